# Optimizing an MI355X kernel written in HIP

```python
import numpy as np
import jax
import jax.numpy as jnp
from jax import lax

D_MODEL = 1024
BATCH = 2
SEQ = 8192
DEPTH = 2

HEAD_DIM = 64
N_HEADS_A = D_MODEL // (2 * HEAD_DIM)
N_KV_GROUPS = 2
HEADS_PER_GROUP = N_HEADS_A // N_KV_GROUPS
A_WIDTH = N_HEADS_A * HEAD_DIM
KV_WIDTH = N_KV_GROUPS * HEAD_DIM
ROPE_DIM = HEAD_DIM // 4
ROPE_THETA = 500000.0
CMP_BLOCK = 32
CMP_STRIDE = 16
CMP_HIDDEN = 2 * HEAD_DIM
SEL_BLOCK = 64
SEL_TOPK = 16
WINDOW = 512
Q_CHUNK = 128
N_BRANCH = 3
CONV_WIDTH = 3
B_WIDTH = D_MODEL - A_WIDTH
P_IN = A_WIDTH + 6 * KV_WIDTH + N_BRANCH * N_HEADS_A + 3 * B_WIDTH
POOL_WINDOWS = (2, 4, 8, 16)
POOL_GROUP = D_MODEL // len(POOL_WINDOWS)
D_FF = 2816
N_EVEN = (DEPTH + 1) // 2
N_ODD = DEPTH // 2
EPS = 1e-6
NEG = -1e30

kernel_name = 'hybrid_nsa_shortconv_pool_macaron'


def rms_norm(x, g):
    xf = x.astype(jnp.float32)
    y = xf * lax.rsqrt(jnp.mean(xf * xf, axis=-1, keepdims=True) + EPS)
    return (y * g.astype(jnp.float32)).astype(x.dtype)


def swiglu(h, wg, wu, wd):
    return (jax.nn.silu(h @ wg) * (h @ wu)) @ wd


def rope_tables(pos):
    freqs = ROPE_THETA ** (-jnp.arange(0, ROPE_DIM, 2, dtype=jnp.float32) / ROPE_DIM)
    ang = pos.astype(jnp.float32)[..., None] * freqs
    return jnp.cos(ang), jnp.sin(ang)


def apply_partial_rope(x, cos, sin):
    half = ROPE_DIM // 2
    shp = cos.shape[:2] + (1,) * (x.ndim - 3) + (half,)
    c = cos.reshape(shp)
    s = sin.reshape(shp)
    xf = x.astype(jnp.float32)
    x1, x2, rest = xf[..., :half], xf[..., half:ROPE_DIM], xf[..., ROPE_DIM:]
    out = jnp.concatenate([x1 * c - x2 * s, x2 * c + x1 * s, rest], axis=-1)
    return out.astype(x.dtype)


def cmp_block_index(seq):
    n_cmp = (seq - CMP_BLOCK) // CMP_STRIDE + 1
    return np.arange(n_cmp)[:, None] * CMP_STRIDE + np.arange(CMP_BLOCK)[None, :]


def compress(kv, pos_emb, w1, w2, idx):
    bsz = kv.shape[0]
    blocks = kv[:, idx] + pos_emb[None, None, :, None, :]
    blocks = blocks.transpose(0, 1, 3, 2, 4).reshape(bsz, idx.shape[0], N_KV_GROUPS, CMP_BLOCK * HEAD_DIM)
    return jax.nn.gelu(blocks @ w1) @ w2


def masked_softmax(s, mask):
    return jax.nn.softmax(jnp.where(mask, s.astype(jnp.float32), NEG), axis=-1)


def nsa_core(q, kc, vc, ks, vs, kw, vw, gates, blk_end):
    bsz, seq = q.shape[0], q.shape[1]
    n_chunks = seq // Q_CHUNK
    n_sel = seq // SEL_BLOCK
    k_eff = min(SEL_TOPK, n_sel)
    scale = HEAD_DIM ** -0.5
    G, Hg, d = N_KV_GROUPS, HEADS_PER_GROUP, HEAD_DIM

    cmp_start = np.arange(blk_end.shape[0]) * CMP_STRIDE
    sel_start_np = np.arange(n_sel) * SEL_BLOCK
    overlap = jnp.asarray(((cmp_start[:, None] < sel_start_np[None, :] + SEL_BLOCK)
                           & (cmp_start[:, None] + CMP_BLOCK > sel_start_np[None, :])).astype(np.float32))
    sel_start = jnp.asarray(sel_start_np)
    blk_end_j = jnp.asarray(blk_end)

    ks_blocks = ks.reshape(bsz, n_sel, SEL_BLOCK, G, d).transpose(0, 3, 1, 2, 4)
    vs_blocks = vs.reshape(bsz, n_sel, SEL_BLOCK, G, d).transpose(0, 3, 1, 2, 4)
    kw_pad = jnp.pad(kw, ((0, 0), (WINDOW, 0), (0, 0), (0, 0)))
    vw_pad = jnp.pad(vw, ((0, 0), (WINDOW, 0), (0, 0), (0, 0)))
    gather_blocks = jax.vmap(jax.vmap(lambda blocks, ix: blocks[ix]))

    def chunk(args):
        c, q_c, g_c = args
        t = c * Q_CHUNK + jnp.arange(Q_CHUNK)

        s = jnp.einsum('bqghd,bngd->bghqn', q_c, kc) * scale
        valid = blk_end_j[None, :] <= t[:, None]
        p_cmp = masked_softmax(s, valid) * jnp.any(valid, axis=-1)[:, None].astype(jnp.float32)
        o_cmp = jnp.einsum('bghqn,bngd->bqghd', p_cmp.astype(vc.dtype), vc)

        imp = jnp.einsum('bghqn,nm->bgqm', p_cmp, overlap)
        cur = (t // SEL_BLOCK) * SEL_BLOCK
        forced = (sel_start[None, :] == cur[:, None]) | (sel_start[None, :] == 0)
        imp = jnp.where(sel_start[None, :] <= t[:, None], imp, -1.0)
        imp = jnp.where(forced, 1e4, imp)
        _, sel = lax.top_k(imp, k_eff)
        kg = gather_blocks(ks_blocks, sel)
        vg = gather_blocks(vs_blocks, sel).reshape(bsz, G, Q_CHUNK, k_eff * SEL_BLOCK, d)
        kpos = sel[..., None] * SEL_BLOCK + jnp.arange(SEL_BLOCK)
        mask_s = (kpos <= t[:, None, None]).reshape(bsz, G, 1, Q_CHUNK, k_eff * SEL_BLOCK)
        s = jnp.einsum('bqghd,bgqksd->bghqks', q_c, kg) * scale
        s = s.reshape(bsz, G, Hg, Q_CHUNK, k_eff * SEL_BLOCK)
        p = masked_softmax(s, mask_s)
        o_slc = jnp.einsum('bghqj,bgqjd->bqghd', p.astype(vg.dtype), vg)

        kwc = lax.dynamic_slice_in_dim(kw_pad, c * Q_CHUNK, WINDOW + Q_CHUNK, axis=1)
        vwc = lax.dynamic_slice_in_dim(vw_pad, c * Q_CHUNK, WINDOW + Q_CHUNK, axis=1)
        kpos_w = c * Q_CHUNK - WINDOW + jnp.arange(WINDOW + Q_CHUNK)
        diff = t[:, None] - kpos_w[None, :]
        mask_w = (diff >= 0) & (diff < WINDOW) & (kpos_w[None, :] >= 0)
        s = jnp.einsum('bqghd,bkgd->bghqk', q_c, kwc) * scale
        p = masked_softmax(s, mask_w)
        o_win = jnp.einsum('bghqk,bkgd->bqghd', p.astype(vwc.dtype), vwc)

        return g_c[..., 0:1] * o_cmp + g_c[..., 1:2] * o_slc + g_c[..., 2:3] * o_win

    q_chunks = q.reshape(bsz, n_chunks, Q_CHUNK, G, Hg, d).swapaxes(0, 1)
    g_chunks = gates.reshape(bsz, n_chunks, Q_CHUNK, G, Hg, N_BRANCH).swapaxes(0, 1)
    out = lax.map(chunk, (jnp.arange(n_chunks), q_chunks, g_chunks))
    return out.swapaxes(0, 1).reshape(bsz, seq, A_WIDTH)


def causal_shift(v, n):
    return jnp.pad(v, ((0, 0), (n, 0), (0, 0)))[:, :v.shape[1]]


def hybrid_mixer(h, positions, w_in, q_norm, k_norm, cmp_pos, cmp_w1, cmp_w2, conv_w, w_out):
    bsz, seq, _ = h.shape
    G, Hg, d = N_KV_GROUPS, HEADS_PER_GROUP, HEAD_DIM
    proj = h @ w_in
    sizes = [A_WIDTH] + [KV_WIDTH] * 6 + [N_BRANCH * N_HEADS_A] + [B_WIDTH] * 3
    q, kc, vc, ks, vs, kw, vw, gates, u, gate_b, gate_c = jnp.split(
        proj, np.cumsum(sizes)[:-1].tolist(), axis=-1)

    cos, sin = rope_tables(positions)
    q = apply_partial_rope(rms_norm(q.reshape(bsz, seq, G, Hg, d), q_norm), cos, sin)
    ks = apply_partial_rope(rms_norm(ks.reshape(bsz, seq, G, d), k_norm[1]), cos, sin)
    kw = apply_partial_rope(rms_norm(kw.reshape(bsz, seq, G, d), k_norm[2]), cos, sin)
    vs = vs.reshape(bsz, seq, G, d)
    vw = vw.reshape(bsz, seq, G, d)
    idx = cmp_block_index(seq)
    blk_end = idx[:, -1]
    kc = compress(kc.reshape(bsz, seq, G, d), cmp_pos[0], cmp_w1[0], cmp_w2[0], idx)
    vc = compress(vc.reshape(bsz, seq, G, d), cmp_pos[1], cmp_w1[1], cmp_w2[1], idx)
    cos_c, sin_c = rope_tables(positions[:, blk_end])
    kc = apply_partial_rope(rms_norm(kc, k_norm[0]), cos_c, sin_c)
    gates = jax.nn.sigmoid(gates.astype(jnp.float32)).reshape(bsz, seq, G, Hg, N_BRANCH).astype(h.dtype)
    o_a = nsa_core(q, kc, vc, ks, vs, kw, vw, gates, blk_end)

    v = gate_c * u
    y = conv_w[2] * v + conv_w[1] * causal_shift(v, 1) + conv_w[0] * causal_shift(v, 2)
    o_b = gate_b * y

    return jnp.concatenate([o_a, o_b], axis=-1) @ w_out


def pool_mixer(h, w, scale):
    seq = h.shape[1]
    hf = h.astype(jnp.float32)
    cs = jnp.concatenate([jnp.zeros_like(hf[:, :1]), jnp.cumsum(hf, axis=1)], axis=1)
    t = np.arange(seq)
    outs = []
    for gi, win in enumerate(POOL_WINDOWS):
        sl = slice(gi * POOL_GROUP, (gi + 1) * POOL_GROUP)
        lo = np.maximum(t + 1 - win, 0)
        cnt = jnp.asarray(np.minimum(t + 1, win).astype(np.float32))
        mean = (cs[:, 1:, sl] - cs[:, lo, sl]) / cnt[None, :, None]
        outs.append((mean - hf[..., sl]).astype(h.dtype) @ w[gi])
    return jnp.concatenate(outs, axis=-1) * scale


def setup_inputs(seed: int = 0) -> dict:
    key = jax.random.key(seed)
    ks = jax.random.split(key, 20)
    f32 = jnp.float32

    def nrm(k, shape, fan_in):
        return jax.random.normal(k, shape, f32) * (fan_in ** -0.5)

    def gain(k, shape):
        return 1.0 + 0.02 * jax.random.normal(k, shape, f32)

    x = jax.random.normal(ks[0], (BATCH, SEQ, D_MODEL), f32)
    positions = jnp.broadcast_to(jnp.arange(SEQ, dtype=jnp.int32), (BATCH, SEQ))
    return {
        'x': x,
        'positions': positions,
        'ffn_norm': gain(ks[1], (DEPTH, 2, D_MODEL)),
        'ffn_w_gate': nrm(ks[2], (DEPTH, 2, D_MODEL, D_FF), D_MODEL),
        'ffn_w_up': nrm(ks[3], (DEPTH, 2, D_MODEL, D_FF), D_MODEL),
        'ffn_w_down': nrm(ks[4], (DEPTH, 2, D_FF, D_MODEL), D_FF),
        'mix_norm': gain(ks[5], (DEPTH, D_MODEL)),
        'hyb_w_in': nrm(ks[6], (N_EVEN, D_MODEL, P_IN), D_MODEL),
        'hyb_q_norm': gain(ks[7], (N_EVEN, HEAD_DIM)),
        'hyb_k_norm': gain(ks[8], (N_EVEN, N_BRANCH, HEAD_DIM)),
        'hyb_cmp_pos': 0.02 * jax.random.normal(ks[9], (N_EVEN, 2, CMP_BLOCK, HEAD_DIM), f32),
        'hyb_cmp_w1': nrm(ks[10], (N_EVEN, 2, CMP_BLOCK * HEAD_DIM, CMP_HIDDEN), CMP_BLOCK * HEAD_DIM),
        'hyb_cmp_w2': nrm(ks[11], (N_EVEN, 2, CMP_HIDDEN, HEAD_DIM), CMP_HIDDEN),
        'hyb_conv_w': nrm(ks[12], (N_EVEN, CONV_WIDTH, B_WIDTH), CONV_WIDTH),
        'hyb_w_out': nrm(ks[13], (N_EVEN, A_WIDTH + B_WIDTH, D_MODEL), A_WIDTH + B_WIDTH),
        'pool_w': nrm(ks[14], (N_ODD, len(POOL_WINDOWS), POOL_GROUP, POOL_GROUP), POOL_GROUP),
        'pool_scale': 0.5 + 0.05 * jax.random.normal(ks[15], (N_ODD, D_MODEL), f32),
    }


def reference(x, positions, ffn_norm, ffn_w_gate, ffn_w_up, ffn_w_down, mix_norm,
              hyb_w_in, hyb_q_norm, hyb_k_norm, hyb_cmp_pos, hyb_cmp_w1, hyb_cmp_w2,
              hyb_conv_w, hyb_w_out, pool_w, pool_scale):
    for layer in range(DEPTH):
        h = rms_norm(x, ffn_norm[layer, 0])
        x = x + 0.5 * swiglu(h, ffn_w_gate[layer, 0], ffn_w_up[layer, 0], ffn_w_down[layer, 0])
        h = rms_norm(x, mix_norm[layer])
        i = layer // 2
        if layer % 2 == 0:
            x = x + hybrid_mixer(h, positions, hyb_w_in[i], hyb_q_norm[i], hyb_k_norm[i],
                                 hyb_cmp_pos[i], hyb_cmp_w1[i], hyb_cmp_w2[i],
                                 hyb_conv_w[i], hyb_w_out[i])
        else:
            x = x + pool_mixer(h, pool_w[i], pool_scale[i])
        h = rms_norm(x, ffn_norm[layer, 1])
        x = x + 0.5 * swiglu(h, ffn_w_gate[layer, 1], ffn_w_up[layer, 1], ffn_w_down[layer, 1])
    return x
```

```cpp
#include <hip/hip_runtime.h>
#include <hip/hip_cooperative_groups.h>
#include <cstdio>
#include <cstdint>
namespace cg = cooperative_groups;

#define LAS __attribute__((address_space(3)))
typedef unsigned short bf16_t;
typedef short bf16x8 __attribute__((ext_vector_type(8)));
typedef float f32x4 __attribute__((ext_vector_type(4)));
typedef float f32x2 __attribute__((ext_vector_type(2)));
typedef unsigned u32x4 __attribute__((ext_vector_type(4)));
typedef unsigned u32x2 __attribute__((ext_vector_type(2)));

constexpr int SEQ = 8192, MTOK = 16384, DM = 1024, DFF = 2816, PIN = 2840, PINP = 3072;
constexpr size_t MiB = 1u << 20;
constexpr size_t WS_WGU = 1 * MiB;
constexpr size_t WS_WD = 45 * MiB;
constexpr size_t WS_WIN = 67 * MiB;
constexpr size_t WS_WOUT = 73 * MiB;
constexpr size_t WS_WP = 75 * MiB;
constexpr size_t WS_WC1 = 75 * MiB + 512 * 1024;
constexpr size_t WS_MISC = 77 * MiB;
constexpr size_t WS_SS = 78 * MiB;
constexpr size_t WS_R1 = 80 * MiB;
constexpr size_t WS_XB = 176 * MiB;
constexpr size_t WS_AO = 208 * MiB;
constexpr int LDS_BYTES = 147456;
constexpr int LDS_ST_OFF = LDS_BYTES - 64;
#ifndef NPH_RUN
#define NPH_RUN 15
#endif

__device__ __forceinline__ unsigned f2bf(float f) { unsigned u = __builtin_bit_cast(unsigned, f); return (u + 0x7fffu + ((u >> 16) & 1u)) >> 16; }
typedef float f32x2_t __attribute__((ext_vector_type(2))); typedef __bf16 bf16x2_t __attribute__((ext_vector_type(2)));
__device__ __forceinline__ unsigned cvt_pk_bf16(float lo, float hi) { f32x2_t v = {lo, hi}; bf16x2_t b = __builtin_convertvector(v, bf16x2_t); return __builtin_bit_cast(unsigned, b); }
__device__ __forceinline__ unsigned pk2(float lo, float hi) { return cvt_pk_bf16(lo, hi); }
__device__ __forceinline__ float bf2f(unsigned short h) { return __builtin_bit_cast(float, (unsigned)h << 16); }
__device__ __forceinline__ float bflo(unsigned w) { return __builtin_bit_cast(float, w << 16); }
__device__ __forceinline__ float bfhi(unsigned w) { return __builtin_bit_cast(float, w & 0xffff0000u); }
__device__ __forceinline__ f32x4 mfma16(bf16x8 a, bf16x8 b, f32x4 c) { return __builtin_amdgcn_mfma_f32_16x16x32_bf16(a, b, c, 0, 0, 0); }
#define LDS_WAIT() asm volatile("s_waitcnt lgkmcnt(0)" ::: "memory")
__device__ __forceinline__ float wave_sum(float v) {
#pragma unroll
    for (int o = 1; o < 64; o <<= 1) v += __shfl_xor(v, o);
    return v;
}
__device__ __forceinline__ float wave_max(float v) {
#pragma unroll
    for (int o = 1; o < 64; o <<= 1) v = fmaxf(v, __shfl_xor(v, o));
    return v;
}

struct Args { const float* in[17]; float* out; unsigned char* ws; };

namespace pg8 {
constexpr int BM = 256, BK = 64, HALF = 128, HTB = HALF * BK * 2, STAGE_BYTES = 8 * HTB, NXCD = 8, WGM = 8;
__device__ __forceinline__ int lds_byte(int r, int c) { const int st = (r >> 4) * 2 + (c >> 5), rr = r & 15, cc = c & 31, ob = rr * 64 + cc * 2; return st * 1024 + (ob ^ (((ob >> 9) & 1) << 5)); }
__device__ __forceinline__ void stage_rc(int b, int& R, int& C) { const int st = b / 1024, sb = b % 1024, swz = sb ^ (((sb >> 9) & 1) << 5); R = (st >> 1) * 16 + swz / 64; C = (st & 1) * 32 + (swz % 64) / 2; }
__device__ __forceinline__ int perm32(int rho) { const int n = rho >> 4, i = rho & 15; return 8 * (i >> 2) + 4 * n + (i & 3); }
struct Unit { int pm, pn; };
struct Gemm { const bf16_t* A; const bf16_t* Bt; int M, N, K, lda, ldb, a_pn_off; };
struct StaticOrder {
    int nM, nN, nwg, G, c;
    __device__ void init(int M, int N, int G_, int c_) { nM = M / BM; nN = N / BM; nwg = nM * nN; G = G_; c = c_; }
    __device__ bool next(int i, Unit& u) const {
        const long L = (long)i * G + c; if (L >= nwg) return false;
        int wgid = (int)L; { const int q = nwg / NXCD, r = nwg % NXCD, xcd = wgid % NXCD, off = wgid / NXCD; wgid = (xcd < r ? xcd * (q + 1) : r * (q + 1) + (xcd - r) * q) + off; }
        const int nig = WGM * nN, gid = wgid / nig, fm = gid * WGM, gsz = (nM - fm) < WGM ? (nM - fm) : WGM;
        u.pm = fm + ((wgid % nig) % gsz); u.pn = (wgid % nig) / gsz; return true;
    }
};
__device__ __forceinline__ float rstd_of(const float* ss, int row) {
    const f32x4* p = (const f32x4*)(ss + (size_t)row * 16);
    const f32x4 a = (p[0] + p[1]) + (p[2] + p[3]);
    return __builtin_amdgcn_rsqf(((a.x + a.y) + (a.z + a.w)) * (1.0f / 1024.0f) + 1e-6f);
}
constexpr int RS_LDS_OFF = STAGE_BYTES;
constexpr int RS_MAX_UNITS = 6;
struct EpiGU {
    static constexpr bool PERM = true, HAS_RS = true;
    bf16_t* O; const float* ss;
    __device__ __forceinline__ void operator()(const f32x4 (&acc)[2][2][4][2], const Unit& u, int wr, int wc, int fr, int fq, const LAS float* rsT) const {
        const int row0 = u.pm * BM + wr * 64 + fr, col0 = u.pn * 128 + wc * 32 + 8 * fq;
#pragma unroll
        for (int ai = 0; ai < 2; ++ai)
#pragma unroll
            for (int m = 0; m < 4; ++m) {
                const int row = row0 + ai * HALF + m * 16; const float rs = rsT[ai * HALF + wr * 64 + m * 16 + fr];
                float o[8];
#pragma unroll
                for (int n = 0; n < 2; ++n)
#pragma unroll
                    for (int i = 0; i < 4; ++i) { const float g = acc[ai][0][m][n][i] * rs, up = acc[ai][1][m][n][i] * rs;
                        o[n * 4 + i] = g * __builtin_amdgcn_rcpf(1.0f + __builtin_amdgcn_exp2f(-1.4426950408889634f * g)) * up; }
                u32x4 w; w.x = cvt_pk_bf16(o[0], o[1]); w.y = cvt_pk_bf16(o[2], o[3]); w.z = cvt_pk_bf16(o[4], o[5]); w.w = cvt_pk_bf16(o[6], o[7]);
                *(u32x4*)(O + (size_t)row * DFF + col0) = w;
            }
    }
};
struct EpiProj {
    static constexpr bool PERM = true, HAS_RS = true;
    bf16_t* O; const float* ss;
    __device__ __forceinline__ void operator()(const f32x4 (&acc)[2][2][4][2], const Unit& u, int wr, int wc, int fr, int fq, const LAS float* rsT) const {
        const int row0 = u.pm * BM + wr * 64 + fr, col0 = u.pn * BM + wc * 32 + 8 * fq;
#pragma unroll
        for (int ai = 0; ai < 2; ++ai)
#pragma unroll
            for (int m = 0; m < 4; ++m) {
                const int row = row0 + ai * HALF + m * 16; const float rs = rsT[ai * HALF + wr * 64 + m * 16 + fr];
#pragma unroll
                for (int bj = 0; bj < 2; ++bj) { const f32x4 v0 = acc[ai][bj][m][0] * rs, v1 = acc[ai][bj][m][1] * rs;
                    u32x4 w; w.x = cvt_pk_bf16(v0[0], v0[1]); w.y = cvt_pk_bf16(v0[2], v0[3]); w.z = cvt_pk_bf16(v1[0], v1[1]); w.w = cvt_pk_bf16(v1[2], v1[3]);
                    *(u32x4*)(O + (size_t)row * PINP + col0 + bj * HALF) = w; }
            }
    }
};
struct EpiRes {
    static constexpr bool PERM = false, HAS_RS = false;
    bf16_t* xb; float* fout; float* ssw; const float* cs; float alpha;
    __device__ __forceinline__ void operator()(const f32x4 (&acc)[2][2][4][2], const Unit& u, int wr, int wc, int fr, int fq, const LAS float* rsT) const {
        const int row0 = u.pm * BM + wr * 64 + fr, col0 = u.pn * BM + wc * 32 + 4 * fq;
#pragma unroll
        for (int ai = 0; ai < 2; ++ai)
#pragma unroll
            for (int m = 0; m < 4; ++m) {
                const int row = row0 + ai * HALF + m * 16; float part = 0.f;
#pragma unroll
                for (int bj = 0; bj < 2; ++bj)
#pragma unroll
                    for (int n = 0; n < 2; ++n) { const int col = col0 + bj * HALF + n * 16; const size_t off = (size_t)row * DM + col;
                        f32x4 v = acc[ai][bj][m][n] * alpha; if (cs) v = v * *(const f32x4*)(cs + col);
                        const u32x2 xo = *(const u32x2*)(xb + off);
                        const f32x4 xn = (f32x4){bflo(xo.x), bfhi(xo.x), bflo(xo.y), bfhi(xo.y)} + v;
                        if (fout) { *(f32x4*)(fout + off) = xn; }
                        else { u32x2 w; w.x = cvt_pk_bf16(xn[0], xn[1]); w.y = cvt_pk_bf16(xn[2], xn[3]); *(u32x2*)(xb + off) = w;
                            const float r0 = bflo(w.x), r1 = bfhi(w.x), r2 = bflo(w.y), r3 = bfhi(w.y);
                            part += (r0 * r0 + r1 * r1) + (r2 * r2 + r3 * r3); } }
                if (ssw) { part += __shfl_xor(part, 16); part += __shfl_xor(part, 32); if (fq == 0) ssw[(size_t)row * 16 + u.pn * 4 + wc] = part; }
            }
    }
};

template <class Epi>
__device__ __forceinline__ void gemm_phase(LAS unsigned char* lds, const Gemm g, const StaticOrder& S, const Epi& E, const int tid) {
    const int wid = __builtin_amdgcn_readfirstlane(tid >> 6), lane = tid & 63, wr = wid >> 2, wc = wid & 3, fr = lane & 15, fq = lane >> 4;
    const int K = g.K, nt = K / BK;
    unsigned voffA[2], voffB[2];
#pragma unroll
    for (int i = 0; i < 2; ++i) { int R, C; stage_rc(tid * 16 + i * 8192, R, C); const int Rb = Epi::PERM ? ((R & ~31) + perm32(R & 31)) : R;
        voffA[i] = (unsigned)(R * g.lda + C) * 2u; voffB[i] = (unsigned)(Rb * g.ldb + C) * 2u; }
    const size_t kstep = (size_t)(BK * 2);
    const size_t hstepA = (size_t)HALF * g.lda * 2, hstepB = (size_t)HALF * g.ldb * 2;
    const size_t tstepA = 2 * hstepA, tstepB = 2 * hstepB;
    const unsigned ldsw = (unsigned)wid * 1024u;
    const int aoff = lds_byte(wr * 64 + fr, fq * 8), boff = lds_byte(wc * 32 + fr, fq * 8);
#define PG8_SA(b, h) (((b) * 2 + (h)) * HTB)
#define PG8_SB(b, h) ((4 + (b) * 2 + (h)) * HTB)
#define PG8_STAGE(bufoff, gbase, voff) do { _Pragma("unroll") for (int _i = 0; _i < 2; ++_i) \
        __builtin_amdgcn_global_load_lds((const unsigned*)((const char*)(gbase) + (voff)[_i]), (LAS unsigned*)(lds + (bufoff) + ldsw + _i * 8192), 16, 0, 0); } while (0)
#define PG8_LDA(dst, b, h) do { _Pragma("unroll") for (int m = 0; m < 4; ++m) _Pragma("unroll") for (int k = 0; k < 2; ++k) dst[m][k] = *(const LAS bf16x8*)(lds + PG8_SA(b, h) + aoff + m * 2048 + k * 1024); } while (0)
#define PG8_LDB(dst, b, h) do { _Pragma("unroll") for (int n = 0; n < 2; ++n) _Pragma("unroll") for (int k = 0; k < 2; ++k) dst[n][k] = *(const LAS bf16x8*)(lds + PG8_SB(b, h) + boff + n * 2048 + k * 1024); } while (0)
#define PG8_MMA(ai, bj, At, Bt) do { __builtin_amdgcn_s_setprio(1); _Pragma("unroll") for (int m = 0; m < 4; ++m) _Pragma("unroll") for (int n = 0; n < 2; ++n) _Pragma("unroll") for (int k = 0; k < 2; ++k) \
        acc[ai][bj][m][n] = __builtin_amdgcn_mfma_f32_16x16x32_bf16(Bt[n][k], At[m][k], acc[ai][bj][m][n], 0, 0, 0); __builtin_amdgcn_s_setprio(0); } while (0)
#define PG8_WAIT_V(n) asm volatile("s_waitcnt vmcnt(" #n ")" ::: "memory")
#define PG8_WAIT_L(n) asm volatile("s_waitcnt lgkmcnt(" #n ")" ::: "memory")
#define PG8_BAR __builtin_amdgcn_s_barrier()
#define PG8_SCHED __builtin_amdgcn_sched_barrier(0)
    Unit cur, nxt; int ui = 0;
    if (!S.next(0, cur)) return;
    if constexpr (Epi::HAS_RS) {
        LAS float* tb = (LAS float*)(lds + RS_LDS_OFF);
        for (int r = tid; r < RS_MAX_UNITS * BM; r += 512) { Unit uu; if (S.next(r >> 8, uu)) tb[r] = rstd_of(E.ss, uu.pm * BM + (r & 255)); }
        __syncthreads();
    }
    f32x4 acc[2][2][4][2];
#pragma unroll
    for (int a = 0; a < 2; ++a)
#pragma unroll
        for (int b = 0; b < 2; ++b)
#pragma unroll
            for (int m = 0; m < 4; ++m)
#pragma unroll
                for (int n = 0; n < 2; ++n) acc[a][b][m][n] = (f32x4){0.f, 0.f, 0.f, 0.f};
    bf16x8 At[4][2], B0[2][2], B1[2][2];
    const char* cA = (const char*)g.A + (size_t)cur.pm * tstepA + (size_t)cur.pn * g.a_pn_off * 2; const char* cB = (const char*)g.Bt + (size_t)cur.pn * tstepB;
    PG8_STAGE(PG8_SB(0, 0), cB, voffB); PG8_STAGE(PG8_SB(0, 1), cB + hstepB, voffB); PG8_STAGE(PG8_SA(0, 0), cA, voffA); PG8_STAGE(PG8_SA(0, 1), cA + hstepA, voffA);
    if (wr == 1) PG8_BAR;
    PG8_WAIT_V(2); PG8_BAR;
    PG8_STAGE(PG8_SB(1, 0), cB + kstep, voffB); PG8_STAGE(PG8_SA(1, 0), cA + kstep, voffA); PG8_STAGE(PG8_SB(1, 1), cB + hstepB + kstep, voffB);
    PG8_WAIT_V(6); PG8_BAR;
    for (;;) {
        const bool has_next = S.next(ui + 1, nxt);
        const char* nA = has_next ? (const char*)g.A + (size_t)nxt.pm * tstepA + (size_t)nxt.pn * g.a_pn_off * 2 : cA; const char* nB = has_next ? (const char*)g.Bt + (size_t)nxt.pn * tstepB : cB;
        for (int t = 0; t < nt; t += 2) {
            const bool last = (t == nt - 2);
            const char* a1 = cA + (size_t)(t + 1) * kstep;
            const char* a2 = last ? nA : cA + (size_t)(t + 2) * kstep; const char* b2 = last ? nB : cB + (size_t)(t + 2) * kstep;
            const char* a3 = a2 + kstep; const char* b3 = b2 + kstep;
            PG8_LDB(B0, 0, 0); PG8_LDB(B1, 0, 1); PG8_SCHED; PG8_LDA(At, 0, 0); PG8_STAGE(PG8_SA(1, 1), a1 + hstepA, voffA);
            PG8_WAIT_V(8); PG8_WAIT_L(0); PG8_BAR; PG8_MMA(0, 0, At, B0); PG8_MMA(0, 1, At, B1); PG8_BAR; PG8_SCHED;
            PG8_LDA(At, 0, 1); PG8_STAGE(PG8_SB(0, 0), b2, voffB); PG8_STAGE(PG8_SB(0, 1), b2 + hstepB, voffB); PG8_STAGE(PG8_SA(0, 0), a2, voffA);
            PG8_WAIT_V(8); PG8_WAIT_L(0); PG8_BAR; PG8_MMA(1, 0, At, B0); PG8_MMA(1, 1, At, B1); PG8_BAR; PG8_SCHED;
            PG8_LDB(B0, 1, 0); PG8_LDB(B1, 1, 1); PG8_SCHED; PG8_LDA(At, 1, 0); PG8_STAGE(PG8_SA(0, 1), a2 + hstepA, voffA);
            PG8_WAIT_V(8); PG8_WAIT_L(0); PG8_BAR; PG8_MMA(0, 0, At, B0); PG8_MMA(0, 1, At, B1); PG8_BAR; PG8_SCHED;
            PG8_LDA(At, 1, 1); PG8_STAGE(PG8_SB(1, 0), b3, voffB); PG8_STAGE(PG8_SB(1, 1), b3 + hstepB, voffB); PG8_STAGE(PG8_SA(1, 0), a3, voffA);
            PG8_WAIT_V(8); PG8_WAIT_L(0); PG8_BAR; PG8_MMA(1, 0, At, B0); PG8_MMA(1, 1, At, B1); PG8_BAR; PG8_SCHED;
        }
        if (wr == 0) PG8_BAR;
        E(acc, cur, wr, wc, fr, fq, (const LAS float*)(lds + RS_LDS_OFF) + ui * BM);
        if (!has_next) break;
#pragma unroll
        for (int a = 0; a < 2; ++a)
#pragma unroll
            for (int b = 0; b < 2; ++b)
#pragma unroll
                for (int m = 0; m < 4; ++m)
#pragma unroll
                    for (int n = 0; n < 2; ++n) acc[a][b][m][n] = (f32x4){0.f, 0.f, 0.f, 0.f};
        cur = nxt; cA = nA; cB = nB; ++ui;
        if (wr == 1) PG8_BAR;
    }
    PG8_WAIT_V(0);
    PG8_BAR;
#undef PG8_SA
#undef PG8_SB
#undef PG8_STAGE
#undef PG8_LDA
#undef PG8_LDB
#undef PG8_MMA
#undef PG8_WAIT_V
#undef PG8_WAIT_L
#undef PG8_BAR
#undef PG8_SCHED
}
}

__device__ __forceinline__ void tr_item(const float* __restrict__ W, int ldw, int nvalid, int k0, int n0, bf16_t* WT, int ldk, int drow0,
                                        const float* gain, float* scr, int lane) {
    const int r = lane >> 4, c4 = (lane & 15) * 4;
    f32x4 v[16];
    const bool ok = (n0 + c4) < nvalid;
#pragma unroll
    for (int i = 0; i < 16; ++i) v[i] = ok ? *(const f32x4*)(W + (size_t)(k0 + 4 * i + r) * ldw + n0 + c4) : (f32x4){0.f, 0.f, 0.f, 0.f};
#pragma unroll
    for (int i = 0; i < 16; ++i) { const int kk = 4 * i + r; const float gm = gain ? gain[k0 + kk] : 1.0f; float* d = scr + kk * 65 + c4;
        d[0] = v[i].x * gm; d[1] = v[i].y * gm; d[2] = v[i].z * gm; d[3] = v[i].w * gm; }
    LDS_WAIT();
    const int c = lane & 7;
#pragma unroll
    for (int j = 0; j < 8; ++j) { const int n = (lane >> 3) + 8 * j; const float* p = scr + (8 * c) * 65 + n;
        u32x4 o; o.x = pk2(p[0 * 65], p[1 * 65]); o.y = pk2(p[2 * 65], p[3 * 65]); o.z = pk2(p[4 * 65], p[5 * 65]); o.w = pk2(p[6 * 65], p[7 * 65]);
        *(u32x4*)(WT + (size_t)(drow0 + n) * ldk + k0 + 8 * c) = o; }
    LDS_WAIT();
}

__device__ __forceinline__ void convert_ffn(const Args& a, unsigned char* ws, float* scr, int f, int wk, int nw, int lane, int lo_item = 0, int hi_item = 16 * 88 + 44 * 16) {
    constexpr int I_GU = 16 * 88, I_D = 44 * 16;
    for (int it = lo_item + wk; it < hi_item; it += nw) {
        int r = it;
        if (r < I_GU) { const int kb = r / 88, nb = r % 88, which = nb / 44, n0 = 64 * (nb % 44);
            const float* W = (which ? a.in[4] : a.in[3]) + (size_t)f * DM * DFF;
            tr_item(W, DFF, DFF, 64 * kb, n0, (bf16_t*)(ws + WS_WGU + (size_t)f * 11 * MiB), DM, 256 * (n0 >> 7) + 128 * which + (n0 & 127), a.in[2] + f * DM, scr, lane); continue; }
        r -= I_GU;
        { const int kb = r / 16, nb = r % 16;
            tr_item(a.in[5] + (size_t)f * DFF * DM, DM, DM, 64 * kb, 64 * nb, (bf16_t*)(ws + WS_WD + (size_t)f * (11 * MiB / 2)), DFF, 64 * nb, nullptr, scr, lane); }
    }
}

__device__ __forceinline__ void convert_misc(const Args& a, unsigned char* ws, float* scr, int wk, int nw, int lane) {
    constexpr int I_IN = 16 * 48, I_OUT = 16 * 16, I_P = 64, I_C = 128;
    constexpr int NITEMS = I_IN + I_OUT + I_P + I_C;
    for (int it = wk; it < NITEMS; it += nw) {
        int r = it;
        if (r < I_IN) { const int kb = r / 48, nb = r % 48;
            tr_item(a.in[7], PIN, PIN, 64 * kb, 64 * nb, (bf16_t*)(ws + WS_WIN), DM, 64 * nb, a.in[6], scr, lane); continue; }
        r -= I_IN;
        if (r < I_OUT) { const int kb = r / 16, nb = r % 16;
            tr_item(a.in[14], DM, DM, 64 * kb, 64 * nb, (bf16_t*)(ws + WS_WOUT), DM, 64 * nb, nullptr, scr, lane); continue; }
        r -= I_OUT;
        if (r < I_P) { const int gi = r / 16, rr = r % 16, kb = rr / 4, nb = rr % 4;
            tr_item(a.in[15] + (size_t)gi * 65536, 256, 256, 64 * kb, 64 * nb, (bf16_t*)(ws + WS_WP), 256, gi * 256 + 64 * nb, nullptr, scr, lane); continue; }
        r -= I_P;
        { const int kv = r / 64, rr = r % 64, kb = rr / 2, nb = rr % 2;
            tr_item(a.in[11] + (size_t)kv * 2048 * 128, 128, 128, 64 * kb, 64 * nb, (bf16_t*)(ws + WS_WC1), 2048, kv * 128 + 64 * nb, nullptr, scr, lane); }
    }
    if (wk < 256) { const int kv = wk >> 7, j = wk & 127; const float* pos = a.in[10] + kv * 2048; const float* w1 = a.in[11] + (size_t)kv * 2048 * 128;
        float s = 0.f; for (int k = lane; k < 2048; k += 64) s += pos[k] * w1[(size_t)k * 128 + j];
        s = wave_sum(s); if (lane == 0) ((float*)(ws + WS_MISC))[wk] = s; }
}

__device__ __forceinline__ void prologue(const Args& a, unsigned char* ws, unsigned char* lds, int bid, int wave, int lane, bool late) {
    float* scr = (float*)(lds + wave * 16640);
    const int gw = bid * 8 + wave, NGW = gridDim.x * 8;
    if (late) convert_ffn(a, ws, scr, 0, gw, NGW, lane, 0, 16 * 88);
    else for (int f = 0; f < 4; ++f) convert_ffn(a, ws, scr, f, gw, NGW, lane);
    if (!late) convert_misc(a, ws, scr, gw, NGW, lane);
    const float* x = a.in[0]; bf16_t* XB = (bf16_t*)(ws + WS_XB); float* SS = (float*)(ws + WS_SS);
    for (int m = gw; m < MTOK; m += 2 * NGW) {
        f32x4 v[2][4];
#pragma unroll
        for (int q = 0; q < 2; ++q)
#pragma unroll
            for (int j = 0; j < 4; ++j) v[q][j] = (m + q * NGW < MTOK) ? ((const f32x4*)(x + (size_t)(m + q * NGW) * DM) + lane)[64 * j] : (f32x4){0.f, 0.f, 0.f, 0.f};
#pragma unroll
        for (int q = 0; q < 2; ++q) { const int mm = m + q * NGW; if (mm >= MTOK) break; float s = 0.f; u32x2* o8 = (u32x2*)(XB + (size_t)mm * DM) + lane;
#pragma unroll
            for (int j = 0; j < 4; ++j) { const f32x4 t = v[q][j]; s += (t.x * t.x + t.y * t.y) + (t.z * t.z + t.w * t.w);
                u32x2 w; w.x = pk2(t.x, t.y); w.y = pk2(t.z, t.w); o8[64 * j] = w; }
            s = wave_sum(s);
            if (lane < 16) SS[(size_t)mm * 16 + lane] = (lane == 0) ? s : 0.f; }
    }
}

__device__ __forceinline__ void post_tile(const Args& a, unsigned char* ws, unsigned char* lds, int tile, const int tid) {
    const bf16_t* PROJ = (const bf16_t*)(ws + WS_R1);
    unsigned char* mx = (unsigned char*)a.out;
    bf16_t* Qo = (bf16_t*)mx; bf16_t* KS = (bf16_t*)(mx + 16 * MiB); bf16_t* KW = (bf16_t*)(mx + 20 * MiB);
    bf16_t* VST = (bf16_t*)(mx + 24 * MiB); bf16_t* VWT = (bf16_t*)(mx + 28 * MiB); bf16_t* AO = (bf16_t*)(ws + WS_AO);
    const int row0 = tile * 64, b = row0 >> 13, tpos0 = row0 & (SEQ - 1);
    float* cs = (float*)lds; float* sn = cs + 512;
    { const int tl = tid >> 3, i = tid & 7; const float pos = (float)((const int*)a.in[1])[row0 + tl];
      const float freq = powf(500000.0f, -(float)i * 0.125f); float s, c; sincosf(pos * freq, &s, &c); cs[tl * 8 + i] = c; sn[tl * 8 + i] = s; }
    __syncthreads();
    const float qscale = 0.125f * 1.4426950408889634f;
    const int j = tid & 7;
    float gq8[8], gs8[8], gw8[8];
#pragma unroll
    for (int i = 0; i < 8; ++i) { gq8[i] = a.in[8][8 * j + i]; gs8[i] = a.in[9][64 + 8 * j + i]; gw8[i] = a.in[9][128 + 8 * j + i]; }
#pragma unroll 4
    for (int pass = 0; pass < 12; ++pass) {
        const int unit = pass * 64 + (tid >> 3), tl = unit / 12, hu = unit % 12;
        const int col = hu < 8 ? 64 * hu : (hu < 10 ? 768 + 64 * (hu - 8) : 1024 + 64 * (hu - 10));
        const u32x4 raw = *(const u32x4*)(PROJ + (size_t)(row0 + tl) * PINP + col + 8 * j);
        float v[8] = {bflo(raw.x), bfhi(raw.x), bflo(raw.y), bfhi(raw.y), bflo(raw.z), bfhi(raw.z), bflo(raw.w), bfhi(raw.w)};
        float ss = 0.f;
#pragma unroll
        for (int i = 0; i < 8; ++i) ss += v[i] * v[i];
        ss += __shfl_xor(ss, 1); ss += __shfl_xor(ss, 2); ss += __shfl_xor(ss, 4);
        const float rstd = 1.0f / sqrtf(ss * (1.0f / 64.0f) + 1e-6f);
#pragma unroll
        for (int i = 0; i < 8; ++i) v[i] = v[i] * rstd * (hu < 8 ? gq8[i] : (hu < 10 ? gs8[i] : gw8[i]));
#pragma unroll
        for (int i = 0; i < 8; ++i) { const float pr = __shfl_xor(v[i], 1); const float c = cs[tl * 8 + i], s = sn[tl * 8 + i];
            if (j == 0) v[i] = v[i] * c - pr * s; else if (j == 1) v[i] = v[i] * c + pr * s; }
        const float sc = hu < 8 ? qscale : 1.0f;
        u32x4 o; o.x = pk2(v[0] * sc, v[1] * sc); o.y = pk2(v[2] * sc, v[3] * sc); o.z = pk2(v[4] * sc, v[5] * sc); o.w = pk2(v[6] * sc, v[7] * sc);
        bf16_t* dst = hu < 8 ? Qo + (size_t)(row0 + tl) * 512 + 64 * hu : (hu < 10 ? KS + (size_t)(row0 + tl) * 128 + 64 * (hu - 8) : KW + (size_t)(row0 + tl) * 128 + 64 * (hu - 10));
        *(u32x4*)(dst + 8 * j) = o;
    }
    for (int k = 0; k < 4; ++k) { const int u = tid + 512 * k, du = u & 255, tc = u >> 8, src = du >> 6, d = du & 63;
        const int col = (src < 2 ? 896 : 1152) + (src & 1) * 64 + d;
        unsigned short v[8];
#pragma unroll
        for (int i = 0; i < 8; ++i) v[i] = PROJ[(size_t)(row0 + 8 * tc + i) * PINP + col];
        u32x4 o; o.x = v[0] | ((unsigned)v[1] << 16); o.y = v[2] | ((unsigned)v[3] << 16); o.z = v[4] | ((unsigned)v[5] << 16); o.w = v[6] | ((unsigned)v[7] << 16);
        bf16_t* dst = (src < 2 ? VST : VWT) + ((size_t)(b * 2 + (src & 1)) * 64 + d) * SEQ + tpos0 + 8 * tc;
        *(u32x4*)dst = o; }
    { const int c = 2 * (tid & 255), th = tid >> 8; const float* cw = a.in[13];
      const f32x2 w0 = *(const f32x2*)(cw + c), w1 = *(const f32x2*)(cw + 512 + c), w2 = *(const f32x2*)(cw + 1024 + c);
      const int r0 = row0 + 32 * th;
      f32x2 v1 = {0.f, 0.f}, v2 = {0.f, 0.f};
      if (tpos0 + 32 * th > 0) { const bf16_t* p1 = PROJ + (size_t)(r0 - 1) * PINP; const bf16_t* p2 = PROJ + (size_t)(r0 - 2) * PINP;
          const unsigned g1 = *(const unsigned*)(p1 + 2328 + c), u1 = *(const unsigned*)(p1 + 1304 + c), g2 = *(const unsigned*)(p2 + 2328 + c), u2 = *(const unsigned*)(p2 + 1304 + c);
          v1 = (f32x2){bflo(g1) * bflo(u1), bfhi(g1) * bfhi(u1)}; v2 = (f32x2){bflo(g2) * bflo(u2), bfhi(g2) * bfhi(u2)}; }
#pragma unroll 1
      for (int tb = 0; tb < 32; tb += 8) {
          unsigned uu[8], gb[8], gc[8];
#pragma unroll
          for (int i = 0; i < 8; ++i) { const bf16_t* p = PROJ + (size_t)(r0 + tb + i) * PINP; uu[i] = *(const unsigned*)(p + 1304 + c); gb[i] = *(const unsigned*)(p + 1816 + c); gc[i] = *(const unsigned*)(p + 2328 + c); }
#pragma unroll
          for (int i = 0; i < 8; ++i) { const f32x2 v = (f32x2){bflo(gc[i]) * bflo(uu[i]), bfhi(gc[i]) * bfhi(uu[i])};
              const f32x2 y = w2 * v + w1 * v1 + w0 * v2;
              *(unsigned*)(AO + (size_t)(r0 + tb + i) * DM + 512 + c) = pk2(bflo(gb[i]) * y.x, bfhi(gb[i]) * y.y); v2 = v1; v1 = v; } } }
    __syncthreads();
}

__device__ __forceinline__ void compress_task(const Args& a, unsigned char* ws, unsigned char* lds, int task, const int tid) {
    const int wave = tid >> 6, lane = tid & 63, fr = lane & 15, fq = lane >> 4;
    const bf16_t* PROJ = (const bf16_t*)(ws + WS_R1); const bf16_t* WC1 = (const bf16_t*)(ws + WS_WC1);
    const float* bias1 = (const float*)(ws + WS_MISC);
    bf16_t* KC = (bf16_t*)(ws + WS_MISC + 64 * 1024); bf16_t* VCT = (bf16_t*)(ws + WS_MISC + 512 * 1024);
    const int kv = task >> 7, b = (task >> 6) & 1, g = (task >> 5) & 1, n0 = (task & 31) * 16;
    bf16_t* Hs = (bf16_t*)lds;
    float* Os = (float*)(lds + 8192);
    float* Ps = (float*)(lds + 16384);
    {
        f32x4 acc[8];
#pragma unroll
        for (int nt = 0; nt < 8; ++nt) acc[nt] = (f32x4){0.f, 0.f, 0.f, 0.f};
        const bf16_t* ap = PROJ + 512 + kv * 128 + g * 64 + 8 * fq;
        const bf16_t* bp = WC1 + (size_t)(kv * 128 + fr) * 2048 + 256 * wave + 8 * fq;
        const int n = n0 + fr;
#pragma unroll 2
        for (int ks = 0; ks < 8; ++ks) { const int kk = 8 * wave + ks; int tok = 16 * n + (kk >> 1); tok = tok > SEQ - 1 ? SEQ - 1 : tok;
            const bf16x8 af = *(const bf16x8*)(ap + (size_t)(b * SEQ + tok) * PINP + (kk & 1) * 32);
            bf16x8 bfr[8];
#pragma unroll
            for (int nt = 0; nt < 8; ++nt) bfr[nt] = *(const bf16x8*)(bp + (size_t)nt * 16 * 2048 + ks * 32);
#pragma unroll
            for (int nt = 0; nt < 8; ++nt) acc[nt] = mfma16(af, bfr[nt], acc[nt]); }
#pragma unroll
        for (int nt = 0; nt < 8; ++nt)
#pragma unroll
            for (int jj = 0; jj < 4; ++jj) Ps[(wave * 16 + 4 * fq + jj) * 132 + 16 * nt + fr] = acc[nt][jj];
    }
    __syncthreads();
    {
        const int row = tid >> 5, col = (tid & 31) * 4;
        f32x4 sm = {0.f, 0.f, 0.f, 0.f};
#pragma unroll
        for (int w = 0; w < 8; ++w) sm += *(const f32x4*)(Ps + (w * 16 + row) * 132 + col);
        unsigned short hv[4];
#pragma unroll
        for (int i = 0; i < 4; ++i) { const float x = sm[i] + bias1[kv * 128 + col + i]; const float u = 0.7978845608028654f * (x + 0.044715f * x * x * x);
            const float th = 1.0f - 2.0f / (__expf(2.0f * u) + 1.0f); hv[i] = (unsigned short)f2bf(0.5f * x * (1.0f + th)); }
        u32x2 o; o.x = hv[0] | ((unsigned)hv[1] << 16); o.y = hv[2] | ((unsigned)hv[3] << 16);
        *(u32x2*)(Hs + row * 136 + col) = o;
    }
    __syncthreads();
    if (wave < 4) { const int dt = wave; f32x4 acc = {0.f, 0.f, 0.f, 0.f}; const float* w2 = a.in[12] + (size_t)kv * 128 * 64;
#pragma unroll
        for (int kk = 0; kk < 4; ++kk) { const bf16x8 af = *(const bf16x8*)(Hs + fr * 136 + kk * 32 + 8 * fq);
            float wv[8];
#pragma unroll
            for (int i = 0; i < 8; ++i) wv[i] = w2[(size_t)(kk * 32 + 8 * fq + i) * 64 + 16 * dt + fr];
            u32x4 bw; bw.x = pk2(wv[0], wv[1]); bw.y = pk2(wv[2], wv[3]); bw.z = pk2(wv[4], wv[5]); bw.w = pk2(wv[6], wv[7]);
            acc = mfma16(af, __builtin_bit_cast(bf16x8, bw), acc); }
#pragma unroll
        for (int jj = 0; jj < 4; ++jj) Os[(4 * fq + jj) * 65 + 16 * dt + fr] = acc[jj]; }
    __syncthreads();
    if (kv == 0) {
        if (tid < 128) { const int nl = tid >> 3, j = tid & 7, n = n0 + nl; float v[8]; float ss = 0.f;
#pragma unroll
            for (int i = 0; i < 8; ++i) { v[i] = Os[nl * 65 + 8 * j + i]; ss += v[i] * v[i]; }
            ss += __shfl_xor(ss, 1); ss += __shfl_xor(ss, 2); ss += __shfl_xor(ss, 4);
            const float rstd = 1.0f / sqrtf(ss * (1.0f / 64.0f) + 1e-6f);
            int ptok = 16 * n + 31; ptok = ptok > SEQ - 1 ? SEQ - 1 : ptok;
            const float pos = (float)((const int*)a.in[1])[b * SEQ + ptok];
#pragma unroll
            for (int i = 0; i < 8; ++i) v[i] = v[i] * rstd * a.in[9][8 * j + i];
#pragma unroll
            for (int i = 0; i < 8; ++i) { const float pr = __shfl_xor(v[i], 1);
                if (j < 2) { const float freq = powf(500000.0f, -(float)i * 0.125f); float s, c; sincosf(pos * freq, &s, &c);
                    v[i] = (j == 0) ? v[i] * c - pr * s : v[i] * c + pr * s; } }
            u32x4 o; o.x = pk2(v[0], v[1]); o.y = pk2(v[2], v[3]); o.z = pk2(v[4], v[5]); o.w = pk2(v[6], v[7]);
            if (n >= 511) o = (u32x4){0u, 0u, 0u, 0u};
            *(u32x4*)(KC + ((size_t)(b * 512 + n) * 2 + g) * 64 + 8 * j) = o; }
    } else {
        if (tid < 64) { const int d = tid; unsigned w[8];
#pragma unroll
            for (int i = 0; i < 8; ++i) { const float v0 = (n0 + 2 * i >= 511) ? 0.f : Os[(2 * i) * 65 + d], v1 = (n0 + 2 * i + 1 >= 511) ? 0.f : Os[(2 * i + 1) * 65 + d]; w[i] = pk2(v0, v1); }
            u32x4* dst = (u32x4*)(VCT + ((size_t)(b * 2 + g) * 64 + d) * 512 + n0);
            dst[0] = (u32x4){w[0], w[1], w[2], w[3]}; dst[1] = (u32x4){w[4], w[5], w[6], w[7]}; }
    }
    __syncthreads();
}

constexpr int AT_TPS = 2, AT_TILE = 18432, AT_STAGE = AT_TPS * AT_TILE, AT_FIN = 2 * AT_STAGE, AT_IMP_STRIDE = 8256, AT_SELM = AT_FIN + 8 * AT_IMP_STRIDE;
struct AttnPtrs { const bf16_t *Q, *KS, *KW, *VST, *VWT, *KC, *VCT, *PROJ; bf16_t* AO; const float *qn, *kn; };

template <int MODE, bool MASKED>
__device__ __forceinline__ void attn_tile(const unsigned char* buf, int key0, int lane, const bf16x8 (&Q)[2][2], f32x4 (&O)[2][4], float (&l)[2],
                                          float ci, int lo, unsigned cnt, const float (&inv)[2], float* imp, float& prev) {
    const int fr = lane & 15, fq = lane >> 4;
    bf16x8 kf[4][2];
#pragma unroll
    for (int kt = 0; kt < 4; ++kt)
#pragma unroll
        for (int ds = 0; ds < 2; ++ds) kf[kt][ds] = *(const bf16x8*)(buf + (16 * kt + fr) * 144 + 64 * ds + 16 * fq);
    bool vm[16];
    if (MASKED) {
#pragma unroll
        for (int i = 0; i < 16; ++i) vm[i] = (unsigned)(key0 + 16 * (i >> 2) + 4 * fq + (i & 3) - lo) < cnt;
    }
    float w[16];
#pragma unroll
    for (int i = 0; i < 16; ++i) w[i] = 0.f;
    u32x4 pk[2][2];
#pragma unroll
    for (int h = 0; h < 2; ++h) {
        f32x4 sc[4];
#pragma unroll
        for (int kt = 0; kt < 4; ++kt) { f32x4 t = {ci, ci, ci, ci}; t = mfma16(kf[kt][0], Q[h][0], t); sc[kt] = mfma16(kf[kt][1], Q[h][1], t); }
        float p[16];
#pragma unroll
        for (int kt = 0; kt < 4; ++kt)
#pragma unroll
            for (int i = 0; i < 4; ++i) { const float e = __builtin_amdgcn_exp2f(sc[kt][i]); p[4 * kt + i] = MASKED ? (vm[4 * kt + i] ? e : 0.f) : e; }
        if (MODE == 1) {
#pragma unroll
            for (int i = 0; i < 16; ++i) { p[i] *= inv[h]; w[i] += p[i]; }
        } else {
            l[h] += (((p[0] + p[1]) + (p[2] + p[3])) + ((p[4] + p[5]) + (p[6] + p[7]))) + (((p[8] + p[9]) + (p[10] + p[11])) + ((p[12] + p[13]) + (p[14] + p[15])));
        }
        if (MODE >= 1) {
#pragma unroll
            for (int hf = 0; hf < 2; ++hf) { pk[h][hf].x = cvt_pk_bf16(p[8 * hf + 0], p[8 * hf + 1]); pk[h][hf].y = cvt_pk_bf16(p[8 * hf + 2], p[8 * hf + 3]);
                pk[h][hf].z = cvt_pk_bf16(p[8 * hf + 4], p[8 * hf + 5]); pk[h][hf].w = cvt_pk_bf16(p[8 * hf + 6], p[8 * hf + 7]); }
        }
    }
    if (MODE >= 1) {
#pragma unroll
        for (int hf = 0; hf < 2; ++hf) {
            bf16x8 vf[4];
#pragma unroll
            for (int dt = 0; dt < 4; ++dt) { const unsigned char* vp = buf + 9216 + (16 * dt + fr) * 144 + (32 * hf + 4 * fq) * 2;
                const u32x2 a0 = *(const u32x2*)vp, a1 = *(const u32x2*)(vp + 32);
                vf[dt] = __builtin_bit_cast(bf16x8, (u32x4){a0.x, a0.y, a1.x, a1.y}); }
#pragma unroll
            for (int dt = 0; dt < 4; ++dt)
#pragma unroll
                for (int h = 0; h < 2; ++h) O[h][dt] = mfma16(vf[dt], __builtin_bit_cast(bf16x8, pk[h][hf]), O[h][dt]);
        }
    }
    if (MODE == 1) {
#pragma unroll
        for (int kt = 0; kt < 4; ++kt) {
            const float w3 = w[4 * kt + 3], sum4 = (w[4 * kt] + w[4 * kt + 1]) + (w[4 * kt + 2] + w3);
            const float rc = __shfl(w3, (lane + 48) & 63), rp = __shfl(prev, (lane + 48) & 63);
            const float spill = fq ? rc : rp; prev = w3;
            imp[fr * 129 + 4 * ((key0 >> 4) + kt) + fq] = sum4 + spill;
        }
    }
}

template <int MODE, bool FLAGGED>
__device__ __forceinline__ void attn_stream(unsigned char* lds, const bf16_t* __restrict__ Kg, const bf16_t* __restrict__ VTg, int vpitch, int kstart, int nst,
                                            const int tid, const int lane, const bf16x8 (&Q)[2][2], f32x4 (&O)[2][4], float (&l)[2], float cinit,
                                            int lo, unsigned cnt, const unsigned long long sel_lo, const unsigned long long sel_hi, int tpos, const float (&inv)[2], float* imp, float& prev) {
    int tid_o = tid, lane_o = lane; asm volatile("" : "+v"(tid_o), "+v"(lane_o));
    const int lr = tid_o >> 3, lc = tid_o & 7, t0w = tpos - (lane & 15);
    const int nstage = (nst + AT_TPS - 1) / AT_TPS;
    {
#pragma unroll
        for (int u = 0; u < AT_TPS; ++u) if (u < nst) {
            const u32x4 kr = *(const u32x4*)(Kg + (size_t)(kstart + 64 * u + lr) * 128 + 8 * lc), vr = *(const u32x4*)(VTg + (size_t)lr * vpitch + kstart + 64 * u + 8 * lc);
            *(u32x4*)(lds + u * AT_TILE + lr * 144 + 16 * lc) = kr; *(u32x4*)(lds + u * AT_TILE + 9216 + lr * 144 + 16 * lc) = vr; }
    }
    __syncthreads();
    for (int sg = 0; sg < nstage; ++sg) {
#pragma unroll 1
        for (int u = 0; u < AT_TPS; ++u) {
            const int ti = sg * AT_TPS + u, tn = ti + AT_TPS;
            const bool pre = tn < nst;
            u32x4 kr, vr;
            if (pre) { kr = *(const u32x4*)(Kg + (size_t)(kstart + 64 * tn + lr) * 128 + 8 * lc); vr = *(const u32x4*)(VTg + (size_t)lr * vpitch + kstart + 64 * tn + 8 * lc); }
            if (ti < nst) {
                const int key0 = kstart + 64 * ti;
                const unsigned char* buf = lds + (sg & 1) * AT_STAGE + u * AT_TILE;
                if (FLAGGED) {
                    const int j = key0 >> 6; const unsigned long long wsel = (j < 64) ? sel_lo : sel_hi;
                    const bool flag = (wsel >> (j & 63)) & 1ull;
                    if (__ballot(flag) != 0ull) {
                        if (key0 + 63 <= t0w) attn_tile<MODE, false>(buf, key0, lane_o, Q, O, l, flag ? cinit : -30000.0f, 0, 0u, inv, imp, prev);
                        else attn_tile<MODE, true>(buf, key0, lane_o, Q, O, l, cinit, 0, flag ? (unsigned)(tpos + 1) : 0u, inv, imp, prev);
                    }
                } else {
                    const bool allv = ((unsigned)(key0 - lo) < cnt) && ((unsigned)(key0 + 63 - lo) < cnt);
                    if (__ballot(!allv) == 0ull) attn_tile<MODE, false>(buf, key0, lane_o, Q, O, l, cinit, lo, cnt, inv, imp, prev);
                    else attn_tile<MODE, true>(buf, key0, lane_o, Q, O, l, cinit, lo, cnt, inv, imp, prev);
                }
            }
            if (pre) { unsigned char* nb = lds + ((sg + 1) & 1) * AT_STAGE + u * AT_TILE;
                *(u32x4*)(nb + lr * 144 + 16 * lc) = kr; *(u32x4*)(nb + 9216 + lr * 144 + 16 * lc) = vr; }
        }
        __syncthreads();
    }
}

__device__ __forceinline__ void attn_chunk(const AttnPtrs& P, unsigned char* lds, int b, int g, int c, const int tid, int wave, int lane) {
    const int fr = lane & 15, fq = lane >> 4, tt = wave & 3, hp = wave >> 2;
    const int t0 = 64 * c + 16 * tt, tpos = t0 + fr;
    const size_t rowbase = (size_t)b * SEQ;
    f32x4* fin = (f32x4*)(lds + AT_FIN + (tt * 2 + hp) * 8192);
    float* imp = (float*)(lds + AT_FIN + (tt * 2 + hp) * AT_IMP_STRIDE);
    const float* impA = (const float*)(lds + AT_FIN + (tt * 2) * AT_IMP_STRIDE);
    const float* impB = (const float*)(lds + AT_FIN + (tt * 2 + 1) * AT_IMP_STRIDE);
    unsigned* selm = (unsigned*)(lds + AT_SELM + tt * 256);
    bf16x8 Q[2][2];
#pragma unroll
    for (int h = 0; h < 2; ++h)
#pragma unroll
        for (int ds = 0; ds < 2; ++ds) Q[h][ds] = *(const bf16x8*)(P.Q + (rowbase + tpos) * 512 + (g * 4 + 2 * hp + h) * 64 + 32 * ds + 8 * fq);
    const float mq = wave_max(fabsf(P.qn[lane]));
    const float c0 = -(8.0f * mq * wave_max(fabsf(P.kn[lane])) * 1.03f * 1.4426950408889634f + 0.1f);
    const float c1 = -(8.0f * mq * wave_max(fabsf(P.kn[64 + lane])) * 1.03f * 1.4426950408889634f + 0.1f);
    const float c2 = -(8.0f * mq * wave_max(fabsf(P.kn[128 + lane])) * 1.03f * 1.4426950408889634f + 0.1f);
    f32x4 O[2][4]; float l[2], inv[2] = {0.f, 0.f}; float prev = 0.f; unsigned long long sel_lo = 0ull, sel_hi = 0ull;
#define ZERO_O() do { _Pragma("unroll") for (int h = 0; h < 2; ++h) { l[h] = 0.f; _Pragma("unroll") for (int dt = 0; dt < 4; ++dt) O[h][dt] = (f32x4){0.f, 0.f, 0.f, 0.f}; } } while (0)
#define REDUCE_L() do { _Pragma("unroll") for (int h = 0; h < 2; ++h) { l[h] += __shfl_xor(l[h], 16); l[h] += __shfl_xor(l[h], 32); } } while (0)
    const bf16_t* KCg = P.KC + (size_t)b * 512 * 128 + g * 64;
    const bf16_t* VCTg = P.VCT + (size_t)(b * 2 + g) * 64 * 512;
    const int nlim = (tpos >= 31) ? ((tpos - 31) >> 4) : -1;
    const int ncs = (4 * c + 3 + 63) >> 6;
    for (int i = lane; i < 16 * 129; i += 64) imp[i] = 0.f;
    ZERO_O();
    attn_stream<0, false>(lds, KCg, VCTg, 512, 0, ncs, tid, lane, Q, O, l, c0, 0, (unsigned)(nlim + 1), sel_lo, sel_hi, tpos, inv, imp, prev);
    REDUCE_L();
#pragma unroll
    for (int h = 0; h < 2; ++h) inv[h] = l[h] > 0.f ? 1.0f / l[h] : 0.f;
    attn_stream<1, false>(lds, KCg, VCTg, 512, 0, ncs, tid, lane, Q, O, l, c0, 0, (unsigned)(nlim + 1), sel_lo, sel_hi, tpos, inv, imp, prev);
    const unsigned long long ltmask = (1ull << lane) - 1ull;
    for (int tk = 8 * hp; tk < 8 * hp + 8; ++tk) {
        const int cur = (t0 + tk) >> 6;
        const float v0 = impA[tk * 129 + lane] + impB[tk * 129 + lane], v1 = impA[tk * 129 + 64 + lane] + impB[tk * 129 + 64 + lane];
        const unsigned k0 = (lane > cur) ? 0u : ((lane == 0 || lane == cur) ? 0x461C4000u : __builtin_bit_cast(unsigned, v0));
        const unsigned k1 = (lane + 64 > cur) ? 0u : ((lane + 64 == cur) ? 0x461C4000u : __builtin_bit_cast(unsigned, v1));
        unsigned T = 0u;
        for (int bit = 30; bit >= 0; --bit) { const unsigned cand = T | (1u << bit);
            const int cntc = __popcll(__ballot(k0 >= cand)) + __popcll(__ballot(k1 >= cand)); if (cntc >= 16) T = cand; }
        const unsigned long long bg0 = __ballot(k0 > T), bg1 = __ballot(k1 > T);
        const int need = 16 - __popcll(bg0) - __popcll(bg1);
        const unsigned long long be0 = __ballot(k0 == T), be1 = __ballot(k1 == T);
        const int r0 = __popcll(be0 & ltmask), r1 = __popcll(be0) + __popcll(be1 & ltmask);
        const bool s0 = (k0 > T) || ((k0 == T) && r0 < need), s1 = (k1 > T) || ((k1 == T) && r1 < need);
        const unsigned long long m0 = __ballot(s0), m1 = __ballot(s1);
        if (lane == 0) { selm[tk * 4 + 0] = (unsigned)m0; selm[tk * 4 + 1] = (unsigned)(m0 >> 32); selm[tk * 4 + 2] = (unsigned)m1; selm[tk * 4 + 3] = (unsigned)(m1 >> 32); }
    }
    __syncthreads();
    sel_lo = (unsigned long long)selm[fr * 4 + 0] | ((unsigned long long)selm[fr * 4 + 1] << 32);
    sel_hi = (unsigned long long)selm[fr * 4 + 2] | ((unsigned long long)selm[fr * 4 + 3] << 32);
    int tpos_l = tpos; asm volatile("" : "+v"(tpos_l));
#define GATE(h, br) (1.0f / (1.0f + __expf(-bf2f(P.PROJ[(rowbase + tpos_l) * PINP + 1280 + g * 12 + hp * 6 + (h) * 3 + (br)]))))
#pragma unroll
    for (int h = 0; h < 2; ++h)
#pragma unroll
        for (int dt = 0; dt < 4; ++dt) fin[(h * 4 + dt) * 64 + lane] = O[h][dt] * GATE(h, 0);
    ZERO_O();
    attn_stream<2, true>(lds, P.KS + rowbase * 128 + g * 64, P.VST + (size_t)(b * 2 + g) * 64 * SEQ, SEQ, 0, c + 1, tid, lane, Q, O, l, c1, 0, 0u, sel_lo, sel_hi, tpos, inv, imp, prev);
    REDUCE_L();
#pragma unroll
    for (int h = 0; h < 2; ++h) { const float sc = GATE(h, 1) / l[h];
#pragma unroll
        for (int dt = 0; dt < 4; ++dt) fin[(h * 4 + dt) * 64 + lane] += O[h][dt] * sc; }
    ZERO_O();
    { int kbeg = 64 * c - 512; kbeg = kbeg < 0 ? 0 : kbeg;
      attn_stream<2, false>(lds, P.KW + rowbase * 128 + g * 64, P.VWT + (size_t)(b * 2 + g) * 64 * SEQ, SEQ, kbeg, (64 * c + 64 - kbeg) >> 6, tid, lane, Q, O, l, c2, tpos - 511, 512u, sel_lo, sel_hi, tpos, inv, imp, prev); }
    REDUCE_L();
    int lane_l = lane; asm volatile("" : "+v"(lane_l), "+v"(tpos_l));
    bf16_t* op = P.AO + (rowbase + tpos_l) * DM + g * 256 + hp * 128 + 4 * (lane_l >> 4);
#pragma unroll
    for (int h = 0; h < 2; ++h) { const float sc = GATE(h, 2) / l[h];
#pragma unroll
        for (int dt = 0; dt < 4; ++dt) { const f32x4 v = fin[(h * 4 + dt) * 64 + lane] + O[h][dt] * sc;
            u32x2 w; w.x = cvt_pk_bf16(v[0], v[1]); w.y = cvt_pk_bf16(v[2], v[3]); *(u32x2*)(op + h * 64 + 16 * dt) = w; } }
    __syncthreads();
#undef ZERO_O
#undef REDUCE_L
#undef GATE
}

__device__ __forceinline__ void pool_tile(const Args& a, unsigned char* ws, unsigned char* lds, int tile, const int tid) {
    const bf16_t* X = (const bf16_t*)(ws + WS_XB); bf16_t* PD = (bf16_t*)(ws + WS_AO); const float* SS = (const float*)(ws + WS_SS);
    const int row0 = tile * 64, tpos0 = row0 & (SEQ - 1);
    float* rs = (float*)lds;
    if (tid < 80) rs[tid] = (tpos0 - 16 + tid >= 0) ? pg8::rstd_of(SS, row0 - 16 + tid) : 0.f;
    __syncthreads();
    const int c = 2 * tid, win = 2 << (c >> 8);
    const f32x2 gn = *(const f32x2*)(a.in[6] + DM + c);
    f32x2 xo[16], xn[16];
#pragma unroll
    for (int j = 0; j < 16; ++j) { const unsigned xw = (tpos0 - 16 + j >= 0) ? *(const unsigned*)(X + (size_t)(row0 - 16 + j) * DM + c) : 0u; xo[j] = (f32x2){bflo(xw), bfhi(xw)} * rs[j]; }
#pragma unroll 1
    for (int sub = 0; sub < 4; ++sub) {
#pragma unroll
        for (int j = 0; j < 16; ++j) { const unsigned xw = *(const unsigned*)(X + (size_t)(row0 + 16 * sub + j) * DM + c); xn[j] = (f32x2){bflo(xw), bfhi(xw)} * rs[16 + 16 * sub + j]; }
#define PX(k) ((k) >= 0 ? xn[(k) >= 0 ? (k) : 0] : xo[(k) >= 0 ? 0 : 16 + (k)])
#pragma unroll
        for (int t = 0; t < 16; ++t) {
            f32x2 sm = xn[t] + PX(t - 1);
            if (win >= 4) sm += PX(t - 2) + PX(t - 3);
            if (win >= 8) sm += (PX(t - 4) + PX(t - 5)) + (PX(t - 6) + PX(t - 7));
            if (win >= 16) sm += ((PX(t - 8) + PX(t - 9)) + (PX(t - 10) + PX(t - 11))) + ((PX(t - 12) + PX(t - 13)) + (PX(t - 14) + PX(t - 15)));
            const int cn = min(tpos0 + 16 * sub + t + 1, win); const float ic = 1.0f / (float)cn;
            const f32x2 o = gn * (sm * ic - xn[t]);
            *(unsigned*)(PD + (size_t)(row0 + 16 * sub + t) * DM + c) = pk2(o.x, o.y);
        }
#undef PX
#pragma unroll
        for (int j = 0; j < 16; ++j) xo[j] = xn[j];
    }
    __syncthreads();
}

#define XB_TMO      128
#define XB_XCNT(j)  (256  + 64 * (j))
#define XB_XSUB(j)  (1280 + 64 * (j))
#define XB_XGEN(j)  (2304 + 64 * (j))
#define XB_TOP      3328
#define XB_TOPGEN   3392
#define XCD_BAR_WORDS 3456
#define XB_SPIN_CAP (1u << 18)
__device__ __forceinline__ unsigned xb_ld(unsigned* p)              { return __hip_atomic_load(p, __ATOMIC_RELAXED, __HIP_MEMORY_SCOPE_AGENT); }
__device__ __forceinline__ unsigned xb_add(unsigned* p, unsigned v) { return __hip_atomic_fetch_add(p, v, __ATOMIC_RELAXED, __HIP_MEMORY_SCOPE_AGENT); }
__device__ __forceinline__ unsigned xb_xcc_id() { return (unsigned)__builtin_amdgcn_s_getreg((3 << 11) | 20) & 0xFu; }
#define XB_SPIN(cond, bar) do { unsigned _sp = 0; while (cond) { __builtin_amdgcn_s_sleep(1); \
    if ((++_sp & 255u) == 0u) { if (xb_ld(&(bar)[XB_TMO])) break; if (_sp > XB_SPIN_CAP) { atomicAdd(&(bar)[XB_TMO], 1u); break; } } } } while (0)
struct XcdBarrier { unsigned* bar; unsigned x; volatile unsigned* st; };
__device__ __forceinline__ void xcd_barrier_complete(unsigned* bar, unsigned x, unsigned& nloc, unsigned& nx) {
    const unsigned G = gridDim.x * gridDim.y * gridDim.z;
    unsigned sum, cnt, mine, sp = 0u;
    for (;;) {
        sum = 0u; cnt = 0u; mine = 0u;
#pragma unroll
        for (unsigned j = 0; j < 16; ++j) { const unsigned c = xb_ld(&bar[XB_XCNT(j)]); sum += c; cnt += (c > 0u) ? 1u : 0u; mine = (j == x) ? c : mine; }
        if (sum == G) break;
        __builtin_amdgcn_s_sleep(1);
        if ((++sp & 255u) == 0u) { if (xb_ld(&bar[XB_TMO])) break; if (sp > XB_SPIN_CAP) { atomicAdd(&bar[XB_TMO], 1u); break; } }
    }
    nloc = mine > 0u ? mine : 1u; nx = cnt > 0u ? cnt : 1u;
}
__device__ __forceinline__ void xcd_barrier(const XcdBarrier& b, const int tid) {
    asm volatile("s_waitcnt vmcnt(0) lgkmcnt(0)" ::: "memory");
    __syncthreads();
    if (tid == 0) {
        unsigned* bar = b.bar;
        __builtin_amdgcn_s_waitcnt(0);
        unsigned nloc = b.st[0], nx = b.st[1];
        if (nloc == 0u) { xcd_barrier_complete(bar, b.x, nloc, nx); b.st[0] = nloc; b.st[1] = nx; }
        const unsigned old = xb_add(&bar[XB_XSUB(b.x)], 1u);
        const unsigned gen = old / nloc;
        if (old + 1u == (gen + 1u) * nloc) {
            __builtin_amdgcn_fence(__ATOMIC_RELEASE, "agent");
            asm volatile("s_waitcnt vmcnt(0)" ::: "memory");
            const unsigned og = xb_add(&bar[XB_TOP], 1u);
            const unsigned tg = og / nx;
            if (og + 1u == (tg + 1u) * nx) xb_add(&bar[XB_TOPGEN], 1u);
            else XB_SPIN(xb_ld(&bar[XB_TOPGEN]) == tg, bar);
            __builtin_amdgcn_fence(__ATOMIC_ACQUIRE, "agent");
            xb_add(&bar[XB_XGEN(b.x)], 1u);
            asm volatile("s_waitcnt vmcnt(0)" ::: "memory");
        } else {
            XB_SPIN(xb_ld(&bar[XB_XGEN(b.x)]) == gen, bar);
            __builtin_amdgcn_fence(__ATOMIC_ACQUIRE, "agent");
            asm volatile("s_waitcnt vmcnt(0)" ::: "memory");
        }
    }
    __syncthreads();
}

__global__ void __launch_bounds__(512, 2) mega_fwd(Args a) {
    extern __shared__ __attribute__((aligned(16))) unsigned char lds[];
    cg::grid_group grid = cg::this_grid();
    const int G = gridDim.x;
    XcdBarrier xbar; xbar.bar = (unsigned*)a.ws; xbar.x = xb_xcc_id(); xbar.st = (volatile unsigned*)(lds + LDS_ST_OFF);
    if (threadIdx.x < 2) xbar.st[threadIdx.x] = 0u;
    if (threadIdx.x == 0) (void)xb_add(&xbar.bar[XB_XCNT(xbar.x)], 1u);
    grid.sync();
#pragma unroll 1
    for (int ph = 0; ph < NPH_RUN; ++ph) {
        int tid = threadIdx.x; asm volatile("" : "+v"(tid));
        int bid = blockIdx.x; asm volatile("" : "+s"(bid));
        size_t ws_o = 0; asm volatile("" : "+s"(ws_o));
        unsigned char* ws = a.ws + ws_o;
        const int wave = __builtin_amdgcn_readfirstlane(tid >> 6), lane = tid & 63;
        bf16_t* XB = (bf16_t*)(ws + WS_XB); float* SS = (float*)(ws + WS_SS); bf16_t* R1 = (bf16_t*)(ws + WS_R1); bf16_t* AO = (bf16_t*)(ws + WS_AO);
        if (ph == 0) {
            prologue(a, ws, lds, bid, wave, lane, G == 256);
        } else if (ph == 1 || ph == 7 || ph == 9 || ph == 13) {
            const int f = ph == 1 ? 0 : ph == 7 ? 1 : ph == 9 ? 2 : 3;
            pg8::Gemm g{XB, (const bf16_t*)(ws + WS_WGU + (size_t)f * 11 * MiB), MTOK, 2 * DFF, DM, DM, DM, 0};
            pg8::StaticOrder S; S.init(MTOK, 2 * DFF, G, bid);
            pg8::EpiGU E{R1, SS};
            pg8::gemm_phase<pg8::EpiGU>((LAS unsigned char*)lds, g, S, E, tid);
            if (G == 256 && f < 3 && bid >= 128) { float* scr = (float*)(lds + wave * 16640); const int wk = (bid - 128) * 8 + wave;
                if (f == 0) { convert_ffn(a, ws, scr, 0, wk, 1024, lane, 16 * 88, 16 * 88 + 44 * 16); convert_misc(a, ws, scr, wk, 1024, lane); }
                convert_ffn(a, ws, scr, f + 1, wk, 1024, lane); }
        } else if (ph == 2 || ph == 6 || ph == 8 || ph == 10 || ph == 12 || ph == 14) {
            pg8::Gemm g; pg8::EpiRes E;
            if (ph == 6) { g = pg8::Gemm{AO, (const bf16_t*)(ws + WS_WOUT), MTOK, DM, DM, DM, DM, 0}; E = pg8::EpiRes{XB, nullptr, SS, nullptr, 1.0f}; }
            else if (ph == 12) { g = pg8::Gemm{AO, (const bf16_t*)(ws + WS_WP), MTOK, DM, 256, DM, 256, 256}; E = pg8::EpiRes{XB, nullptr, SS, a.in[16], 1.0f}; }
            else { const int f = ph == 2 ? 0 : ph == 8 ? 1 : ph == 10 ? 2 : 3;
                g = pg8::Gemm{R1, (const bf16_t*)(ws + WS_WD + (size_t)f * (11 * MiB / 2)), MTOK, DM, DFF, DFF, DFF, 0};
                E = pg8::EpiRes{XB, ph == 14 ? a.out : nullptr, ph == 14 ? nullptr : SS, nullptr, 0.5f}; }
            pg8::StaticOrder S; S.init(MTOK, DM, G, bid);
            pg8::gemm_phase<pg8::EpiRes>((LAS unsigned char*)lds, g, S, E, tid);
        } else if (ph == 3) {
            pg8::Gemm g{XB, (const bf16_t*)(ws + WS_WIN), MTOK, PINP, DM, DM, DM, 0};
            pg8::StaticOrder S; S.init(MTOK, PINP, G, bid);
            pg8::EpiProj E{R1, SS};
            pg8::gemm_phase<pg8::EpiProj>((LAS unsigned char*)lds, g, S, E, tid);
        } else if (ph == 4) {
            for (int s = bid; s < 256; s += G) { post_tile(a, ws, lds, s, tid); compress_task(a, ws, lds, s, tid); }
        } else if (ph == 5) {
            const unsigned char* mx = (const unsigned char*)a.out;
            AttnPtrs P; P.Q = (const bf16_t*)mx; P.KS = (const bf16_t*)(mx + 16 * MiB); P.KW = (const bf16_t*)(mx + 20 * MiB);
            P.VST = (const bf16_t*)(mx + 24 * MiB); P.VWT = (const bf16_t*)(mx + 28 * MiB);
            P.KC = (const bf16_t*)(ws + WS_MISC + 64 * 1024); P.VCT = (const bf16_t*)(ws + WS_MISC + 512 * 1024); P.PROJ = R1; P.AO = AO;
            P.qn = a.in[8]; P.kn = a.in[9];
            for (int s = bid; s < 256; s += G) {
                const int b = (s >> 1) & 1, gq = s & 1, cp = s >> 2;
                attn_chunk(P, lds, b, gq, cp, tid, wave, lane);
                attn_chunk(P, lds, b, gq, 127 - cp, tid, wave, lane);
            }
        } else if (ph == 11) {
            for (int s = bid; s < 256; s += G) pool_tile(a, ws, lds, s, tid);
        }
        if (ph != NPH_RUN - 1) xcd_barrier(xbar, tid);
    }
}

extern "C" void kernel_launch(void* const* d_in, const int* in_sizes, int n_in, void* d_out, int out_size, void* d_ws, size_t ws_size, hipStream_t stream) {
    static int grid = 0;
    if (grid == 0) {
        int dev = 0, cus = 0, per_cu = 0;
        hipGetDevice(&dev);
        hipDeviceGetAttribute(&cus, hipDeviceAttributeMultiprocessorCount, dev);
        hipFuncSetAttribute((const void*)mega_fwd, hipFuncAttributeMaxDynamicSharedMemorySize, LDS_BYTES);
        hipOccupancyMaxActiveBlocksPerMultiprocessor(&per_cu, (const void*)mega_fwd, 512, LDS_BYTES);
        if (per_cu < 1) { fprintf(stderr, "kernel_launch: occupancy query says %d blocks per CU\n", per_cu); per_cu = 1; }
        if (per_cu > 1) per_cu = 1;
        grid = cus * per_cu;
        if (grid > 256) grid = 256;
    }
    (void)hipMemsetAsync(d_ws, 0, 16384, stream);
    Args a{};
    for (int i = 0; i < 17; ++i) a.in[i] = (const float*)d_in[i];
    a.out = (float*)d_out; a.ws = (unsigned char*)d_ws;
    void* args[] = {&a};
    hipError_t e = hipLaunchCooperativeKernel((const void*)mega_fwd, dim3(grid), dim3(512), args, LDS_BYTES, stream);
    if (e != hipSuccess) fprintf(stderr, "cooperative launch failed: %s (grid %d)\n", hipGetErrorString(e), grid);
}
```

```cpp
#include <hip/hip_runtime.h>
#include <hip/hip_cooperative_groups.h>
#include <cstdio>
#include <cstdint>
namespace cg = cooperative_groups;

#define LAS __attribute__((address_space(3)))
typedef unsigned short bf16_t;
typedef short bf16x8 __attribute__((ext_vector_type(8)));
typedef float f32x4 __attribute__((ext_vector_type(4)));
typedef float f32x2 __attribute__((ext_vector_type(2)));
typedef unsigned u32x4 __attribute__((ext_vector_type(4)));
typedef unsigned u32x2 __attribute__((ext_vector_type(2)));

constexpr int SEQ = 8192, MTOK = 16384, DM = 1024, DFF = 2816, PIN = 2840, PINP = 3072;
constexpr size_t MiB = 1u << 20;
constexpr size_t WS_WGU = 1 * MiB;
constexpr size_t WS_WD = 45 * MiB;
constexpr size_t WS_WIN = 67 * MiB;
constexpr size_t WS_WOUT = 73 * MiB;
constexpr size_t WS_WP = 75 * MiB;
constexpr size_t WS_WC1 = 75 * MiB + 512 * 1024;
constexpr size_t WS_MISC = 77 * MiB;
constexpr size_t WS_SS = 78 * MiB;
constexpr size_t WS_R1 = 80 * MiB;
constexpr size_t WS_XB = 176 * MiB;
constexpr size_t WS_AO = 208 * MiB;
constexpr int LDS_BYTES = 147456;
constexpr int LDS_ST_OFF = LDS_BYTES - 64;
#ifndef NPH_RUN
#define NPH_RUN 15
#endif

__device__ __forceinline__ unsigned f2bf(float f) { unsigned u = __builtin_bit_cast(unsigned, f); return (u + 0x7fffu + ((u >> 16) & 1u)) >> 16; }
typedef float f32x2_t __attribute__((ext_vector_type(2))); typedef __bf16 bf16x2_t __attribute__((ext_vector_type(2)));
__device__ __forceinline__ unsigned cvt_pk_bf16(float lo, float hi) { f32x2_t v = {lo, hi}; bf16x2_t b = __builtin_convertvector(v, bf16x2_t); return __builtin_bit_cast(unsigned, b); }
__device__ __forceinline__ unsigned pk2(float lo, float hi) { return cvt_pk_bf16(lo, hi); }
__device__ __forceinline__ float bf2f(unsigned short h) { return __builtin_bit_cast(float, (unsigned)h << 16); }
__device__ __forceinline__ float bflo(unsigned w) { return __builtin_bit_cast(float, w << 16); }
__device__ __forceinline__ float bfhi(unsigned w) { return __builtin_bit_cast(float, w & 0xffff0000u); }
__device__ __forceinline__ f32x4 mfma16(bf16x8 a, bf16x8 b, f32x4 c) { return __builtin_amdgcn_mfma_f32_16x16x32_bf16(a, b, c, 0, 0, 0); }
#define LDS_WAIT() asm volatile("s_waitcnt lgkmcnt(0)" ::: "memory")
__device__ __forceinline__ float wave_sum(float v) {
#pragma unroll
    for (int o = 1; o < 64; o <<= 1) v += __shfl_xor(v, o);
    return v;
}
__device__ __forceinline__ float wave_max(float v) {
#pragma unroll
    for (int o = 1; o < 64; o <<= 1) v = fmaxf(v, __shfl_xor(v, o));
    return v;
}

struct Args { const float* in[17]; float* out; unsigned char* ws; };

namespace pg8 {
constexpr int BM = 256, BK = 64, HALF = 128, HTB = HALF * BK * 2, STAGE_BYTES = 8 * HTB, NXCD = 8, WGM = 8;
__device__ __forceinline__ int lds_byte(int r, int c) { const int st = (r >> 4) * 2 + (c >> 5), rr = r & 15, cc = c & 31, ob = rr * 64 + cc * 2; return st * 1024 + (ob ^ (((ob >> 9) & 1) << 5)); }
__device__ __forceinline__ void stage_rc(int b, int& R, int& C) { const int st = b / 1024, sb = b % 1024, swz = sb ^ (((sb >> 9) & 1) << 5); R = (st >> 1) * 16 + swz / 64; C = (st & 1) * 32 + (swz % 64) / 2; }
__device__ __forceinline__ int perm32(int rho) { const int n = rho >> 4, i = rho & 15; return 8 * (i >> 2) + 4 * n + (i & 3); }
struct Unit { int pm, pn; };
struct Gemm { const bf16_t* A; const bf16_t* Bt; int M, N, K, lda, ldb, a_pn_off; };
struct StaticOrder {
    int nM, nN, nwg, G, c;
    __device__ void init(int M, int N, int G_, int c_) { nM = M / BM; nN = N / BM; nwg = nM * nN; G = G_; c = c_; }
    __device__ bool next(int i, Unit& u) const {
        const long L = (long)i * G + c; if (L >= nwg) return false;
        int wgid = (int)L; { const int q = nwg / NXCD, r = nwg % NXCD, xcd = wgid % NXCD, off = wgid / NXCD; wgid = (xcd < r ? xcd * (q + 1) : r * (q + 1) + (xcd - r) * q) + off; }
        const int nig = WGM * nN, gid = wgid / nig, fm = gid * WGM, gsz = (nM - fm) < WGM ? (nM - fm) : WGM;
        u.pm = fm + ((wgid % nig) % gsz); u.pn = (wgid % nig) / gsz; return true;
    }
};
__device__ __forceinline__ float rstd_of(const float* ss, int row) {
    const f32x4* p = (const f32x4*)(ss + (size_t)row * 16);
    const f32x4 a = (p[0] + p[1]) + (p[2] + p[3]);
    return __builtin_amdgcn_rsqf(((a.x + a.y) + (a.z + a.w)) * (1.0f / 1024.0f) + 1e-6f);
}
constexpr int RS_LDS_OFF = STAGE_BYTES;
constexpr int RS_MAX_UNITS = 6;
struct EpiGU {
    static constexpr bool PERM = true, HAS_RS = true;
    bf16_t* O; const float* ss;
    __device__ __forceinline__ void operator()(const f32x4 (&acc)[2][2][4][2], const Unit& u, int wr, int wc, int fr, int fq, const LAS float* rsT) const {
        const int row0 = u.pm * BM + wr * 64 + fr, col0 = u.pn * 128 + wc * 32 + 8 * fq;
#pragma unroll
        for (int ai = 0; ai < 2; ++ai)
#pragma unroll
            for (int m = 0; m < 4; ++m) {
                const int row = row0 + ai * HALF + m * 16; const float rs = rsT[ai * HALF + wr * 64 + m * 16 + fr];
                float o[8];
#pragma unroll
                for (int n = 0; n < 2; ++n)
#pragma unroll
                    for (int i = 0; i < 4; ++i) { const float g = acc[ai][0][m][n][i] * rs, up = acc[ai][1][m][n][i] * rs;
                        o[n * 4 + i] = g * __builtin_amdgcn_rcpf(1.0f + __builtin_amdgcn_exp2f(-1.4426950408889634f * g)) * up; }
                u32x4 w; w.x = cvt_pk_bf16(o[0], o[1]); w.y = cvt_pk_bf16(o[2], o[3]); w.z = cvt_pk_bf16(o[4], o[5]); w.w = cvt_pk_bf16(o[6], o[7]);
                *(u32x4*)(O + (size_t)row * DFF + col0) = w;
            }
    }
};
struct EpiProj {
    static constexpr bool PERM = true, HAS_RS = true;
    bf16_t* O; const float* ss;
    __device__ __forceinline__ void operator()(const f32x4 (&acc)[2][2][4][2], const Unit& u, int wr, int wc, int fr, int fq, const LAS float* rsT) const {
        const int row0 = u.pm * BM + wr * 64 + fr, col0 = u.pn * BM + wc * 32 + 8 * fq;
#pragma unroll
        for (int ai = 0; ai < 2; ++ai)
#pragma unroll
            for (int m = 0; m < 4; ++m) {
                const int row = row0 + ai * HALF + m * 16; const float rs = rsT[ai * HALF + wr * 64 + m * 16 + fr];
#pragma unroll
                for (int bj = 0; bj < 2; ++bj) { const f32x4 v0 = acc[ai][bj][m][0] * rs, v1 = acc[ai][bj][m][1] * rs;
                    u32x4 w; w.x = cvt_pk_bf16(v0[0], v0[1]); w.y = cvt_pk_bf16(v0[2], v0[3]); w.z = cvt_pk_bf16(v1[0], v1[1]); w.w = cvt_pk_bf16(v1[2], v1[3]);
                    *(u32x4*)(O + (size_t)row * PINP + col0 + bj * HALF) = w; }
            }
    }
};
struct EpiRes {
    static constexpr bool PERM = false, HAS_RS = false;
    bf16_t* xb; float* fout; float* ssw; const float* cs; float alpha;
    __device__ __forceinline__ void operator()(const f32x4 (&acc)[2][2][4][2], const Unit& u, int wr, int wc, int fr, int fq, const LAS float* rsT) const {
        const int row0 = u.pm * BM + wr * 64 + fr, col0 = u.pn * BM + wc * 32 + 4 * fq;
#pragma unroll
        for (int ai = 0; ai < 2; ++ai)
#pragma unroll
            for (int m = 0; m < 4; ++m) {
                const int row = row0 + ai * HALF + m * 16; float part = 0.f;
#pragma unroll
                for (int bj = 0; bj < 2; ++bj)
#pragma unroll
                    for (int n = 0; n < 2; ++n) { const int col = col0 + bj * HALF + n * 16; const size_t off = (size_t)row * DM + col;
                        f32x4 v = acc[ai][bj][m][n] * alpha; if (cs) v = v * *(const f32x4*)(cs + col);
                        const u32x2 xo = *(const u32x2*)(xb + off);
                        const f32x4 xn = (f32x4){bflo(xo.x), bfhi(xo.x), bflo(xo.y), bfhi(xo.y)} + v;
                        if (fout) { *(f32x4*)(fout + off) = xn; }
                        else { u32x2 w; w.x = cvt_pk_bf16(xn[0], xn[1]); w.y = cvt_pk_bf16(xn[2], xn[3]); *(u32x2*)(xb + off) = w;
                            const float r0 = bflo(w.x), r1 = bfhi(w.x), r2 = bflo(w.y), r3 = bfhi(w.y);
                            part += (r0 * r0 + r1 * r1) + (r2 * r2 + r3 * r3); } }
                if (ssw) { part += __shfl_xor(part, 16); part += __shfl_xor(part, 32); if (fq == 0) ssw[(size_t)row * 16 + u.pn * 4 + wc] = part; }
            }
    }
};

template <class Epi>
__device__ __forceinline__ void gemm_phase(LAS unsigned char* lds, const Gemm g, const StaticOrder& S, const Epi& E, const int tid) {
    const int wid = __builtin_amdgcn_readfirstlane(tid >> 6), lane = tid & 63, wr = wid >> 2, wc = wid & 3, fr = lane & 15, fq = lane >> 4;
    const int K = g.K, nt = K / BK;
    unsigned voffA[2], voffB[2];
#pragma unroll
    for (int i = 0; i < 2; ++i) { int R, C; stage_rc(tid * 16 + i * 8192, R, C); const int Rb = Epi::PERM ? ((R & ~31) + perm32(R & 31)) : R;
        voffA[i] = (unsigned)(R * g.lda + C) * 2u; voffB[i] = (unsigned)(Rb * g.ldb + C) * 2u; }
    const size_t kstep = (size_t)(BK * 2);
    const size_t hstepA = (size_t)HALF * g.lda * 2, hstepB = (size_t)HALF * g.ldb * 2;
    const size_t tstepA = 2 * hstepA, tstepB = 2 * hstepB;
    const unsigned ldsw = (unsigned)wid * 1024u;
    const int aoff = lds_byte(wr * 64 + fr, fq * 8), boff = lds_byte(wc * 32 + fr, fq * 8);
#define PG8_SA(b, h) (((b) * 2 + (h)) * HTB)
#define PG8_SB(b, h) ((4 + (b) * 2 + (h)) * HTB)
#define PG8_STAGE(bufoff, gbase, voff) do { _Pragma("unroll") for (int _i = 0; _i < 2; ++_i) \
        __builtin_amdgcn_global_load_lds((const unsigned*)((const char*)(gbase) + (voff)[_i]), (LAS unsigned*)(lds + (bufoff) + ldsw + _i * 8192), 16, 0, 0); } while (0)
#define PG8_LDA(dst, b, h) do { _Pragma("unroll") for (int m = 0; m < 4; ++m) _Pragma("unroll") for (int k = 0; k < 2; ++k) dst[m][k] = *(const LAS bf16x8*)(lds + PG8_SA(b, h) + aoff + m * 2048 + k * 1024); } while (0)
#define PG8_LDB(dst, b, h) do { _Pragma("unroll") for (int n = 0; n < 2; ++n) _Pragma("unroll") for (int k = 0; k < 2; ++k) dst[n][k] = *(const LAS bf16x8*)(lds + PG8_SB(b, h) + boff + n * 2048 + k * 1024); } while (0)
#define PG8_MMA(ai, bj, At, Bt) do { __builtin_amdgcn_s_setprio(1); _Pragma("unroll") for (int m = 0; m < 4; ++m) _Pragma("unroll") for (int n = 0; n < 2; ++n) _Pragma("unroll") for (int k = 0; k < 2; ++k) \
        acc[ai][bj][m][n] = __builtin_amdgcn_mfma_f32_16x16x32_bf16(Bt[n][k], At[m][k], acc[ai][bj][m][n], 0, 0, 0); __builtin_amdgcn_s_setprio(0); } while (0)
#define PG8_WAIT_V(n) asm volatile("s_waitcnt vmcnt(" #n ")" ::: "memory")
#define PG8_WAIT_L(n) asm volatile("s_waitcnt lgkmcnt(" #n ")" ::: "memory")
#define PG8_BAR __builtin_amdgcn_s_barrier()
#define PG8_SCHED __builtin_amdgcn_sched_barrier(0)
    Unit cur, nxt; int ui = 0;
    if (!S.next(0, cur)) return;
    if constexpr (Epi::HAS_RS) {
        LAS float* tb = (LAS float*)(lds + RS_LDS_OFF);
        for (int r = tid; r < RS_MAX_UNITS * BM; r += 512) { Unit uu; if (S.next(r >> 8, uu)) tb[r] = rstd_of(E.ss, uu.pm * BM + (r & 255)); }
        __syncthreads();
    }
    f32x4 acc[2][2][4][2];
#pragma unroll
    for (int a = 0; a < 2; ++a)
#pragma unroll
        for (int b = 0; b < 2; ++b)
#pragma unroll
            for (int m = 0; m < 4; ++m)
#pragma unroll
                for (int n = 0; n < 2; ++n) acc[a][b][m][n] = (f32x4){0.f, 0.f, 0.f, 0.f};
    bf16x8 At[4][2], B0[2][2], B1[2][2];
    const char* cA = (const char*)g.A + (size_t)cur.pm * tstepA + (size_t)cur.pn * g.a_pn_off * 2; const char* cB = (const char*)g.Bt + (size_t)cur.pn * tstepB;
    PG8_STAGE(PG8_SB(0, 0), cB, voffB); PG8_STAGE(PG8_SB(0, 1), cB + hstepB, voffB); PG8_STAGE(PG8_SA(0, 0), cA, voffA); PG8_STAGE(PG8_SA(0, 1), cA + hstepA, voffA);
    if (wr == 1) PG8_BAR;
    PG8_WAIT_V(2); PG8_BAR;
    PG8_STAGE(PG8_SB(1, 0), cB + kstep, voffB); PG8_STAGE(PG8_SA(1, 0), cA + kstep, voffA); PG8_STAGE(PG8_SB(1, 1), cB + hstepB + kstep, voffB);
    PG8_WAIT_V(6); PG8_BAR;
    for (;;) {
        const bool has_next = S.next(ui + 1, nxt);
        const char* nA = has_next ? (const char*)g.A + (size_t)nxt.pm * tstepA + (size_t)nxt.pn * g.a_pn_off * 2 : cA; const char* nB = has_next ? (const char*)g.Bt + (size_t)nxt.pn * tstepB : cB;
        for (int t = 0; t < nt; t += 2) {
            const bool last = (t == nt - 2);
            const char* a1 = cA + (size_t)(t + 1) * kstep;
            const char* a2 = last ? nA : cA + (size_t)(t + 2) * kstep; const char* b2 = last ? nB : cB + (size_t)(t + 2) * kstep;
            const char* a3 = a2 + kstep; const char* b3 = b2 + kstep;
            PG8_LDB(B0, 0, 0); PG8_LDB(B1, 0, 1); PG8_SCHED; PG8_LDA(At, 0, 0); PG8_STAGE(PG8_SA(1, 1), a1 + hstepA, voffA);
            PG8_WAIT_V(8); PG8_WAIT_L(0); PG8_BAR; PG8_MMA(0, 0, At, B0); PG8_MMA(0, 1, At, B1); PG8_BAR; PG8_SCHED;
            PG8_LDA(At, 0, 1); PG8_STAGE(PG8_SB(0, 0), b2, voffB); PG8_STAGE(PG8_SB(0, 1), b2 + hstepB, voffB); PG8_STAGE(PG8_SA(0, 0), a2, voffA);
            PG8_WAIT_V(8); PG8_WAIT_L(0); PG8_BAR; PG8_MMA(1, 0, At, B0); PG8_MMA(1, 1, At, B1); PG8_BAR; PG8_SCHED;
            PG8_LDB(B0, 1, 0); PG8_LDB(B1, 1, 1); PG8_SCHED; PG8_LDA(At, 1, 0); PG8_STAGE(PG8_SA(0, 1), a2 + hstepA, voffA);
            PG8_WAIT_V(8); PG8_WAIT_L(0); PG8_BAR; PG8_MMA(0, 0, At, B0); PG8_MMA(0, 1, At, B1); PG8_BAR; PG8_SCHED;
            PG8_LDA(At, 1, 1); PG8_STAGE(PG8_SB(1, 0), b3, voffB); PG8_STAGE(PG8_SB(1, 1), b3 + hstepB, voffB); PG8_STAGE(PG8_SA(1, 0), a3, voffA);
            PG8_WAIT_V(8); PG8_WAIT_L(0); PG8_BAR; PG8_MMA(1, 0, At, B0); PG8_MMA(1, 1, At, B1); PG8_BAR; PG8_SCHED;
        }
        if (wr == 0) PG8_BAR;
        E(acc, cur, wr, wc, fr, fq, (const LAS float*)(lds + RS_LDS_OFF) + ui * BM);
        if (!has_next) break;
#pragma unroll
        for (int a = 0; a < 2; ++a)
#pragma unroll
            for (int b = 0; b < 2; ++b)
#pragma unroll
                for (int m = 0; m < 4; ++m)
#pragma unroll
                    for (int n = 0; n < 2; ++n) acc[a][b][m][n] = (f32x4){0.f, 0.f, 0.f, 0.f};
        cur = nxt; cA = nA; cB = nB; ++ui;
        if (wr == 1) PG8_BAR;
    }
    PG8_WAIT_V(0);
    PG8_BAR;
#undef PG8_SA
#undef PG8_SB
#undef PG8_STAGE
#undef PG8_LDA
#undef PG8_LDB
#undef PG8_MMA
#undef PG8_WAIT_V
#undef PG8_WAIT_L
#undef PG8_BAR
#undef PG8_SCHED
}
}

__device__ __forceinline__ void tr_item(const float* __restrict__ W, int ldw, int nvalid, int k0, int n0, bf16_t* WT, int ldk, int drow0,
                                        const float* gain, float* scr, int lane) {
    const int r = lane >> 4, c4 = (lane & 15) * 4;
    f32x4 v[16];
    const bool ok = (n0 + c4) < nvalid;
#pragma unroll
    for (int i = 0; i < 16; ++i) v[i] = ok ? *(const f32x4*)(W + (size_t)(k0 + 4 * i + r) * ldw + n0 + c4) : (f32x4){0.f, 0.f, 0.f, 0.f};
#pragma unroll
    for (int i = 0; i < 16; ++i) { const int kk = 4 * i + r; const float gm = gain ? gain[k0 + kk] : 1.0f; float* d = scr + kk * 65 + c4;
        d[0] = v[i].x * gm; d[1] = v[i].y * gm; d[2] = v[i].z * gm; d[3] = v[i].w * gm; }
    LDS_WAIT();
    const int c = lane & 7;
#pragma unroll
    for (int j = 0; j < 8; ++j) { const int n = (lane >> 3) + 8 * j; const float* p = scr + (8 * c) * 65 + n;
        u32x4 o; o.x = pk2(p[0 * 65], p[1 * 65]); o.y = pk2(p[2 * 65], p[3 * 65]); o.z = pk2(p[4 * 65], p[5 * 65]); o.w = pk2(p[6 * 65], p[7 * 65]);
        *(u32x4*)(WT + (size_t)(drow0 + n) * ldk + k0 + 8 * c) = o; }
    LDS_WAIT();
}

__device__ __forceinline__ void convert_ffn(const Args& a, unsigned char* ws, float* scr, int f, int wk, int nw, int lane, int lo_item = 0, int hi_item = 16 * 88 + 44 * 16) {
    constexpr int I_GU = 16 * 88, I_D = 44 * 16;
    for (int it = lo_item + wk; it < hi_item; it += nw) {
        int r = it;
        if (r < I_GU) { const int kb = r / 88, nb = r % 88, which = nb / 44, n0 = 64 * (nb % 44);
            const float* W = (which ? a.in[4] : a.in[3]) + (size_t)f * DM * DFF;
            tr_item(W, DFF, DFF, 64 * kb, n0, (bf16_t*)(ws + WS_WGU + (size_t)f * 11 * MiB), DM, 256 * (n0 >> 7) + 128 * which + (n0 & 127), a.in[2] + f * DM, scr, lane); continue; }
        r -= I_GU;
        { const int kb = r / 16, nb = r % 16;
            tr_item(a.in[5] + (size_t)f * DFF * DM, DM, DM, 64 * kb, 64 * nb, (bf16_t*)(ws + WS_WD + (size_t)f * (11 * MiB / 2)), DFF, 64 * nb, nullptr, scr, lane); }
    }
}

__device__ __forceinline__ void convert_misc(const Args& a, unsigned char* ws, float* scr, int wk, int nw, int lane) {
    constexpr int I_IN = 16 * 48, I_OUT = 16 * 16, I_P = 64, I_C = 128;
    constexpr int NITEMS = I_IN + I_OUT + I_P + I_C;
    for (int it = wk; it < NITEMS; it += nw) {
        int r = it;
        if (r < I_IN) { const int kb = r / 48, nb = r % 48;
            tr_item(a.in[7], PIN, PIN, 64 * kb, 64 * nb, (bf16_t*)(ws + WS_WIN), DM, 64 * nb, a.in[6], scr, lane); continue; }
        r -= I_IN;
        if (r < I_OUT) { const int kb = r / 16, nb = r % 16;
            tr_item(a.in[14], DM, DM, 64 * kb, 64 * nb, (bf16_t*)(ws + WS_WOUT), DM, 64 * nb, nullptr, scr, lane); continue; }
        r -= I_OUT;
        if (r < I_P) { const int gi = r / 16, rr = r % 16, kb = rr / 4, nb = rr % 4;
            tr_item(a.in[15] + (size_t)gi * 65536, 256, 256, 64 * kb, 64 * nb, (bf16_t*)(ws + WS_WP), 256, gi * 256 + 64 * nb, nullptr, scr, lane); continue; }
        r -= I_P;
        { const int kv = r / 64, rr = r % 64, kb = rr / 2, nb = rr % 2;
            tr_item(a.in[11] + (size_t)kv * 2048 * 128, 128, 128, 64 * kb, 64 * nb, (bf16_t*)(ws + WS_WC1), 2048, kv * 128 + 64 * nb, nullptr, scr, lane); }
    }
    if (wk < 256) { const int kv = wk >> 7, j = wk & 127; const float* pos = a.in[10] + kv * 2048; const float* w1 = a.in[11] + (size_t)kv * 2048 * 128;
        float s = 0.f; for (int k = lane; k < 2048; k += 64) s += pos[k] * w1[(size_t)k * 128 + j];
        s = wave_sum(s); if (lane == 0) ((float*)(ws + WS_MISC))[wk] = s; }
}

__device__ __forceinline__ void prologue(const Args& a, unsigned char* ws, unsigned char* lds, int bid, int wave, int lane, bool late) {
    float* scr = (float*)(lds + wave * 16640);
    const int gw = bid * 8 + wave, NGW = gridDim.x * 8;
    if (late) convert_ffn(a, ws, scr, 0, gw, NGW, lane, 0, 16 * 88);
    else for (int f = 0; f < 4; ++f) convert_ffn(a, ws, scr, f, gw, NGW, lane);
    if (!late) convert_misc(a, ws, scr, gw, NGW, lane);
    const float* x = a.in[0]; bf16_t* XB = (bf16_t*)(ws + WS_XB); float* SS = (float*)(ws + WS_SS);
    for (int m = gw; m < MTOK; m += 2 * NGW) {
        f32x4 v[2][4];
#pragma unroll
        for (int q = 0; q < 2; ++q)
#pragma unroll
            for (int j = 0; j < 4; ++j) v[q][j] = (m + q * NGW < MTOK) ? ((const f32x4*)(x + (size_t)(m + q * NGW) * DM) + lane)[64 * j] : (f32x4){0.f, 0.f, 0.f, 0.f};
#pragma unroll
        for (int q = 0; q < 2; ++q) { const int mm = m + q * NGW; if (mm >= MTOK) break; float s = 0.f; u32x2* o8 = (u32x2*)(XB + (size_t)mm * DM) + lane;
#pragma unroll
            for (int j = 0; j < 4; ++j) { const f32x4 t = v[q][j]; s += (t.x * t.x + t.y * t.y) + (t.z * t.z + t.w * t.w);
                u32x2 w; w.x = pk2(t.x, t.y); w.y = pk2(t.z, t.w); o8[64 * j] = w; }
            s = wave_sum(s);
            if (lane < 16) SS[(size_t)mm * 16 + lane] = (lane == 0) ? s : 0.f; }
    }
}

__device__ __forceinline__ void post_tile(const Args& a, unsigned char* ws, unsigned char* lds, int tile, const int tid) {
    const bf16_t* PROJ = (const bf16_t*)(ws + WS_R1);
    unsigned char* mx = (unsigned char*)a.out;
    bf16_t* Qo = (bf16_t*)mx; bf16_t* KS = (bf16_t*)(mx + 16 * MiB); bf16_t* KW = (bf16_t*)(mx + 20 * MiB);
    bf16_t* VST = (bf16_t*)(mx + 24 * MiB); bf16_t* VWT = (bf16_t*)(mx + 28 * MiB); bf16_t* AO = (bf16_t*)(ws + WS_AO);
    const int row0 = tile * 64, b = row0 >> 13, tpos0 = row0 & (SEQ - 1);
    float* cs = (float*)lds; float* sn = cs + 512;
    { const int tl = tid >> 3, i = tid & 7; const float pos = (float)((const int*)a.in[1])[row0 + tl];
      const float freq = powf(500000.0f, -(float)i * 0.125f); float s, c; sincosf(pos * freq, &s, &c); cs[tl * 8 + i] = c; sn[tl * 8 + i] = s; }
    __syncthreads();
    const float qscale = 0.125f * 1.4426950408889634f;
    const int j = tid & 7;
    float gq8[8], gs8[8], gw8[8];
#pragma unroll
    for (int i = 0; i < 8; ++i) { gq8[i] = a.in[8][8 * j + i]; gs8[i] = a.in[9][64 + 8 * j + i]; gw8[i] = a.in[9][128 + 8 * j + i]; }
#pragma unroll 4
    for (int pass = 0; pass < 12; ++pass) {
        const int unit = pass * 64 + (tid >> 3), tl = unit / 12, hu = unit % 12;
        const int col = hu < 8 ? 64 * hu : (hu < 10 ? 768 + 64 * (hu - 8) : 1024 + 64 * (hu - 10));
        const u32x4 raw = *(const u32x4*)(PROJ + (size_t)(row0 + tl) * PINP + col + 8 * j);
        float v[8] = {bflo(raw.x), bfhi(raw.x), bflo(raw.y), bfhi(raw.y), bflo(raw.z), bfhi(raw.z), bflo(raw.w), bfhi(raw.w)};
        float ss = 0.f;
#pragma unroll
        for (int i = 0; i < 8; ++i) ss += v[i] * v[i];
        ss += __shfl_xor(ss, 1); ss += __shfl_xor(ss, 2); ss += __shfl_xor(ss, 4);
        const float rstd = 1.0f / sqrtf(ss * (1.0f / 64.0f) + 1e-6f);
#pragma unroll
        for (int i = 0; i < 8; ++i) v[i] = v[i] * rstd * (hu < 8 ? gq8[i] : (hu < 10 ? gs8[i] : gw8[i]));
#pragma unroll
        for (int i = 0; i < 8; ++i) { const float pr = __shfl_xor(v[i], 1); const float c = cs[tl * 8 + i], s = sn[tl * 8 + i];
            if (j == 0) v[i] = v[i] * c - pr * s; else if (j == 1) v[i] = v[i] * c + pr * s; }
        const float sc = hu < 8 ? qscale : 1.0f;
        u32x4 o; o.x = pk2(v[0] * sc, v[1] * sc); o.y = pk2(v[2] * sc, v[3] * sc); o.z = pk2(v[4] * sc, v[5] * sc); o.w = pk2(v[6] * sc, v[7] * sc);
        bf16_t* dst = hu < 8 ? Qo + (size_t)(row0 + tl) * 512 + 64 * hu : (hu < 10 ? KS + (size_t)(row0 + tl) * 128 + 64 * (hu - 8) : KW + (size_t)(row0 + tl) * 128 + 64 * (hu - 10));
        *(u32x4*)(dst + 8 * j) = o;
    }
    for (int k = 0; k < 4; ++k) { const int u = tid + 512 * k, du = u & 255, tc = u >> 8, src = du >> 6, d = du & 63;
        const int col = (src < 2 ? 896 : 1152) + (src & 1) * 64 + d;
        unsigned short v[8];
#pragma unroll
        for (int i = 0; i < 8; ++i) v[i] = PROJ[(size_t)(row0 + 8 * tc + i) * PINP + col];
        u32x4 o; o.x = v[0] | ((unsigned)v[1] << 16); o.y = v[2] | ((unsigned)v[3] << 16); o.z = v[4] | ((unsigned)v[5] << 16); o.w = v[6] | ((unsigned)v[7] << 16);
        bf16_t* dst = (src < 2 ? VST : VWT) + ((size_t)(b * 2 + (src & 1)) * 64 + d) * SEQ + tpos0 + 8 * tc;
        *(u32x4*)dst = o; }
    { const int c = 2 * (tid & 255), th = tid >> 8; const float* cw = a.in[13];
      const f32x2 w0 = *(const f32x2*)(cw + c), w1 = *(const f32x2*)(cw + 512 + c), w2 = *(const f32x2*)(cw + 1024 + c);
      const int r0 = row0 + 32 * th;
      f32x2 v1 = {0.f, 0.f}, v2 = {0.f, 0.f};
      if (tpos0 + 32 * th > 0) { const bf16_t* p1 = PROJ + (size_t)(r0 - 1) * PINP; const bf16_t* p2 = PROJ + (size_t)(r0 - 2) * PINP;
          const unsigned g1 = *(const unsigned*)(p1 + 2328 + c), u1 = *(const unsigned*)(p1 + 1304 + c), g2 = *(const unsigned*)(p2 + 2328 + c), u2 = *(const unsigned*)(p2 + 1304 + c);
          v1 = (f32x2){bflo(g1) * bflo(u1), bfhi(g1) * bfhi(u1)}; v2 = (f32x2){bflo(g2) * bflo(u2), bfhi(g2) * bfhi(u2)}; }
#pragma unroll 1
      for (int tb = 0; tb < 32; tb += 8) {
          unsigned uu[8], gb[8], gc[8];
#pragma unroll
          for (int i = 0; i < 8; ++i) { const bf16_t* p = PROJ + (size_t)(r0 + tb + i) * PINP; uu[i] = *(const unsigned*)(p + 1304 + c); gb[i] = *(const unsigned*)(p + 1816 + c); gc[i] = *(const unsigned*)(p + 2328 + c); }
#pragma unroll
          for (int i = 0; i < 8; ++i) { const f32x2 v = (f32x2){bflo(gc[i]) * bflo(uu[i]), bfhi(gc[i]) * bfhi(uu[i])};
              const f32x2 y = w2 * v + w1 * v1 + w0 * v2;
              *(unsigned*)(AO + (size_t)(r0 + tb + i) * DM + 512 + c) = pk2(bflo(gb[i]) * y.x, bfhi(gb[i]) * y.y); v2 = v1; v1 = v; } } }
    __syncthreads();
}

__device__ __forceinline__ void compress_task(const Args& a, unsigned char* ws, unsigned char* lds, int task, const int tid) {
    const int wave = tid >> 6, lane = tid & 63, fr = lane & 15, fq = lane >> 4;
    const bf16_t* PROJ = (const bf16_t*)(ws + WS_R1); const bf16_t* WC1 = (const bf16_t*)(ws + WS_WC1);
    const float* bias1 = (const float*)(ws + WS_MISC);
    bf16_t* KC = (bf16_t*)(ws + WS_MISC + 64 * 1024); bf16_t* VCT = (bf16_t*)(ws + WS_MISC + 512 * 1024);
    const int kv = task >> 7, b = (task >> 6) & 1, g = (task >> 5) & 1, n0 = (task & 31) * 16;
    bf16_t* Hs = (bf16_t*)lds;
    float* Os = (float*)(lds + 8192);
    float* Ps = (float*)(lds + 16384);
    {
        f32x4 acc[8];
#pragma unroll
        for (int nt = 0; nt < 8; ++nt) acc[nt] = (f32x4){0.f, 0.f, 0.f, 0.f};
        const bf16_t* ap = PROJ + 512 + kv * 128 + g * 64 + 8 * fq;
        const bf16_t* bp = WC1 + (size_t)(kv * 128 + fr) * 2048 + 256 * wave + 8 * fq;
        const int n = n0 + fr;
#pragma unroll 2
        for (int ks = 0; ks < 8; ++ks) { const int kk = 8 * wave + ks; int tok = 16 * n + (kk >> 1); tok = tok > SEQ - 1 ? SEQ - 1 : tok;
            const bf16x8 af = *(const bf16x8*)(ap + (size_t)(b * SEQ + tok) * PINP + (kk & 1) * 32);
            bf16x8 bfr[8];
#pragma unroll
            for (int nt = 0; nt < 8; ++nt) bfr[nt] = *(const bf16x8*)(bp + (size_t)nt * 16 * 2048 + ks * 32);
#pragma unroll
            for (int nt = 0; nt < 8; ++nt) acc[nt] = mfma16(af, bfr[nt], acc[nt]); }
#pragma unroll
        for (int nt = 0; nt < 8; ++nt)
#pragma unroll
            for (int jj = 0; jj < 4; ++jj) Ps[(wave * 16 + 4 * fq + jj) * 132 + 16 * nt + fr] = acc[nt][jj];
    }
    __syncthreads();
    {
        const int row = tid >> 5, col = (tid & 31) * 4;
        f32x4 sm = {0.f, 0.f, 0.f, 0.f};
#pragma unroll
        for (int w = 0; w < 8; ++w) sm += *(const f32x4*)(Ps + (w * 16 + row) * 132 + col);
        unsigned short hv[4];
#pragma unroll
        for (int i = 0; i < 4; ++i) { const float x = sm[i] + bias1[kv * 128 + col + i]; const float u = 0.7978845608028654f * (x + 0.044715f * x * x * x);
            const float th = 1.0f - 2.0f / (__expf(2.0f * u) + 1.0f); hv[i] = (unsigned short)f2bf(0.5f * x * (1.0f + th)); }
        u32x2 o; o.x = hv[0] | ((unsigned)hv[1] << 16); o.y = hv[2] | ((unsigned)hv[3] << 16);
        *(u32x2*)(Hs + row * 136 + col) = o;
    }
    __syncthreads();
    if (wave < 4) { const int dt = wave; f32x4 acc = {0.f, 0.f, 0.f, 0.f}; const float* w2 = a.in[12] + (size_t)kv * 128 * 64;
#pragma unroll
        for (int kk = 0; kk < 4; ++kk) { const bf16x8 af = *(const bf16x8*)(Hs + fr * 136 + kk * 32 + 8 * fq);
            float wv[8];
#pragma unroll
            for (int i = 0; i < 8; ++i) wv[i] = w2[(size_t)(kk * 32 + 8 * fq + i) * 64 + 16 * dt + fr];
            u32x4 bw; bw.x = pk2(wv[0], wv[1]); bw.y = pk2(wv[2], wv[3]); bw.z = pk2(wv[4], wv[5]); bw.w = pk2(wv[6], wv[7]);
            acc = mfma16(af, __builtin_bit_cast(bf16x8, bw), acc); }
#pragma unroll
        for (int jj = 0; jj < 4; ++jj) Os[(4 * fq + jj) * 65 + 16 * dt + fr] = acc[jj]; }
    __syncthreads();
    if (kv == 0) {
        if (tid < 128) { const int nl = tid >> 3, j = tid & 7, n = n0 + nl; float v[8]; float ss = 0.f;
#pragma unroll
            for (int i = 0; i < 8; ++i) { v[i] = Os[nl * 65 + 8 * j + i]; ss += v[i] * v[i]; }
            ss += __shfl_xor(ss, 1); ss += __shfl_xor(ss, 2); ss += __shfl_xor(ss, 4);
            const float rstd = 1.0f / sqrtf(ss * (1.0f / 64.0f) + 1e-6f);
            int ptok = 16 * n + 31; ptok = ptok > SEQ - 1 ? SEQ - 1 : ptok;
            const float pos = (float)((const int*)a.in[1])[b * SEQ + ptok];
#pragma unroll
            for (int i = 0; i < 8; ++i) v[i] = v[i] * rstd * a.in[9][8 * j + i];
#pragma unroll
            for (int i = 0; i < 8; ++i) { const float pr = __shfl_xor(v[i], 1);
                if (j < 2) { const float freq = powf(500000.0f, -(float)i * 0.125f); float s, c; sincosf(pos * freq, &s, &c);
                    v[i] = (j == 0) ? v[i] * c - pr * s : v[i] * c + pr * s; } }
            u32x4 o; o.x = pk2(v[0], v[1]); o.y = pk2(v[2], v[3]); o.z = pk2(v[4], v[5]); o.w = pk2(v[6], v[7]);
            if (n >= 511) o = (u32x4){0u, 0u, 0u, 0u};
            *(u32x4*)(KC + ((size_t)(b * 512 + n) * 2 + g) * 64 + 8 * j) = o; }
    } else {
        if (tid < 64) { const int d = tid; unsigned w[8];
#pragma unroll
            for (int i = 0; i < 8; ++i) { const float v0 = (n0 + 2 * i >= 511) ? 0.f : Os[(2 * i) * 65 + d], v1 = (n0 + 2 * i + 1 >= 511) ? 0.f : Os[(2 * i + 1) * 65 + d]; w[i] = pk2(v0, v1); }
            u32x4* dst = (u32x4*)(VCT + ((size_t)(b * 2 + g) * 64 + d) * 512 + n0);
            dst[0] = (u32x4){w[0], w[1], w[2], w[3]}; dst[1] = (u32x4){w[4], w[5], w[6], w[7]}; }
    }
    __syncthreads();
}

constexpr int AT_TPS = 2, AT_TILE = 18432, AT_STAGE = AT_TPS * AT_TILE, AT_FIN = 2 * AT_STAGE, AT_IMP_STRIDE = 8256, AT_SELM = AT_FIN + 8 * AT_IMP_STRIDE;
struct AttnPtrs { const bf16_t *Q, *KS, *KW, *VST, *VWT, *KC, *VCT, *PROJ; bf16_t* AO; const float *qn, *kn; };

template <int MODE, bool MASKED>
__device__ __forceinline__ void attn_tile(const unsigned char* buf, int key0, int lane, const bf16x8 (&Q)[2][2], f32x4 (&O)[2][4], float (&l)[2],
                                          float ci, int lo, unsigned cnt, const float (&inv)[2], float* imp, float& prev) {
    const int fr = lane & 15, fq = lane >> 4;
    bf16x8 kf[4][2];
#pragma unroll
    for (int kt = 0; kt < 4; ++kt)
#pragma unroll
        for (int ds = 0; ds < 2; ++ds) kf[kt][ds] = *(const bf16x8*)(buf + (16 * kt + fr) * 144 + 64 * ds + 16 * fq);
    bool vm[16];
    if (MASKED) {
#pragma unroll
        for (int i = 0; i < 16; ++i) vm[i] = (unsigned)(key0 + 16 * (i >> 2) + 4 * fq + (i & 3) - lo) < cnt;
    }
    float w[16];
#pragma unroll
    for (int i = 0; i < 16; ++i) w[i] = 0.f;
    u32x4 pk[2][2];
#pragma unroll
    for (int h = 0; h < 2; ++h) {
        f32x4 sc[4];
#pragma unroll
        for (int kt = 0; kt < 4; ++kt) { f32x4 t = {ci, ci, ci, ci}; t = mfma16(kf[kt][0], Q[h][0], t); sc[kt] = mfma16(kf[kt][1], Q[h][1], t); }
        float p[16];
#pragma unroll
        for (int kt = 0; kt < 4; ++kt)
#pragma unroll
            for (int i = 0; i < 4; ++i) { const float e = __builtin_amdgcn_exp2f(sc[kt][i]); p[4 * kt + i] = MASKED ? (vm[4 * kt + i] ? e : 0.f) : e; }
        if (MODE == 1) {
#pragma unroll
            for (int i = 0; i < 16; ++i) { p[i] *= inv[h]; w[i] += p[i]; }
        } else {
            l[h] += (((p[0] + p[1]) + (p[2] + p[3])) + ((p[4] + p[5]) + (p[6] + p[7]))) + (((p[8] + p[9]) + (p[10] + p[11])) + ((p[12] + p[13]) + (p[14] + p[15])));
        }
        if (MODE >= 1) {
#pragma unroll
            for (int hf = 0; hf < 2; ++hf) { pk[h][hf].x = cvt_pk_bf16(p[8 * hf + 0], p[8 * hf + 1]); pk[h][hf].y = cvt_pk_bf16(p[8 * hf + 2], p[8 * hf + 3]);
                pk[h][hf].z = cvt_pk_bf16(p[8 * hf + 4], p[8 * hf + 5]); pk[h][hf].w = cvt_pk_bf16(p[8 * hf + 6], p[8 * hf + 7]); }
        }
    }
    if (MODE >= 1) {
#pragma unroll
        for (int hf = 0; hf < 2; ++hf) {
            bf16x8 vf[4];
#pragma unroll
            for (int dt = 0; dt < 4; ++dt) { const unsigned char* vp = buf + 9216 + (16 * dt + fr) * 144 + (32 * hf + 4 * fq) * 2;
                const u32x2 a0 = *(const u32x2*)vp, a1 = *(const u32x2*)(vp + 32);
                vf[dt] = __builtin_bit_cast(bf16x8, (u32x4){a0.x, a0.y, a1.x, a1.y}); }
#pragma unroll
            for (int dt = 0; dt < 4; ++dt)
#pragma unroll
                for (int h = 0; h < 2; ++h) O[h][dt] = mfma16(vf[dt], __builtin_bit_cast(bf16x8, pk[h][hf]), O[h][dt]);
        }
    }
    if (MODE == 1) {
#pragma unroll
        for (int kt = 0; kt < 4; ++kt) {
            const float w3 = w[4 * kt + 3], sum4 = (w[4 * kt] + w[4 * kt + 1]) + (w[4 * kt + 2] + w3);
            const float rc = __shfl(w3, (lane + 48) & 63), rp = __shfl(prev, (lane + 48) & 63);
            const float spill = fq ? rc : rp; prev = w3;
            imp[fr * 129 + 4 * ((key0 >> 4) + kt) + fq] = sum4 + spill;
        }
    }
}

template <int MODE, bool FLAGGED>
__device__ __forceinline__ void attn_stream(unsigned char* lds, const bf16_t* __restrict__ Kg, const bf16_t* __restrict__ VTg, int vpitch, int kstart, int nst,
                                            const int tid, const int lane, const bf16x8 (&Q)[2][2], f32x4 (&O)[2][4], float (&l)[2], float cinit,
                                            int lo, unsigned cnt, const unsigned long long sel_lo, const unsigned long long sel_hi, int tpos, const float (&inv)[2], float* imp, float& prev) {
    int tid_o = tid, lane_o = lane; asm volatile("" : "+v"(tid_o), "+v"(lane_o));
    const int lr = tid_o >> 3, lc = tid_o & 7, t0w = tpos - (lane & 15);
    const int nstage = (nst + AT_TPS - 1) / AT_TPS;
    {
#pragma unroll
        for (int u = 0; u < AT_TPS; ++u) if (u < nst) {
            const u32x4 kr = *(const u32x4*)(Kg + (size_t)(kstart + 64 * u + lr) * 128 + 8 * lc), vr = *(const u32x4*)(VTg + (size_t)lr * vpitch + kstart + 64 * u + 8 * lc);
            *(u32x4*)(lds + u * AT_TILE + lr * 144 + 16 * lc) = kr; *(u32x4*)(lds + u * AT_TILE + 9216 + lr * 144 + 16 * lc) = vr; }
    }
    __syncthreads();
    for (int sg = 0; sg < nstage; ++sg) {
#pragma unroll 1
        for (int u = 0; u < AT_TPS; ++u) {
            const int ti = sg * AT_TPS + u, tn = ti + AT_TPS;
            const bool pre = tn < nst;
            u32x4 kr, vr;
            if (pre) { kr = *(const u32x4*)(Kg + (size_t)(kstart + 64 * tn + lr) * 128 + 8 * lc); vr = *(const u32x4*)(VTg + (size_t)lr * vpitch + kstart + 64 * tn + 8 * lc); }
            if (ti < nst) {
                const int key0 = kstart + 64 * ti;
                const unsigned char* buf = lds + (sg & 1) * AT_STAGE + u * AT_TILE;
                if (FLAGGED) {
                    const int j = key0 >> 6; const unsigned long long wsel = (j < 64) ? sel_lo : sel_hi;
                    const bool flag = (wsel >> (j & 63)) & 1ull;
                    if (__ballot(flag) != 0ull) {
                        if (key0 + 63 <= t0w) attn_tile<MODE, false>(buf, key0, lane_o, Q, O, l, flag ? cinit : -30000.0f, 0, 0u, inv, imp, prev);
                        else attn_tile<MODE, true>(buf, key0, lane_o, Q, O, l, cinit, 0, flag ? (unsigned)(tpos + 1) : 0u, inv, imp, prev);
                    }
                } else {
                    const bool allv = ((unsigned)(key0 - lo) < cnt) && ((unsigned)(key0 + 63 - lo) < cnt);
                    if (__ballot(!allv) == 0ull) attn_tile<MODE, false>(buf, key0, lane_o, Q, O, l, cinit, lo, cnt, inv, imp, prev);
                    else attn_tile<MODE, true>(buf, key0, lane_o, Q, O, l, cinit, lo, cnt, inv, imp, prev);
                }
            }
            if (pre) { unsigned char* nb = lds + ((sg + 1) & 1) * AT_STAGE + u * AT_TILE;
                *(u32x4*)(nb + lr * 144 + 16 * lc) = kr; *(u32x4*)(nb + 9216 + lr * 144 + 16 * lc) = vr; }
        }
        __syncthreads();
    }
}

__device__ __forceinline__ void attn_chunk(const AttnPtrs& P, unsigned char* lds, int b, int g, int c, const int tid, int wave, int lane) {
    const int fr = lane & 15, fq = lane >> 4, tt = wave & 3, hp = wave >> 2;
    const int t0 = 64 * c + 16 * tt, tpos = t0 + fr;
    const size_t rowbase = (size_t)b * SEQ;
    f32x4* fin = (f32x4*)(lds + AT_FIN + (tt * 2 + hp) * 8192);
    float* imp = (float*)(lds + AT_FIN + (tt * 2 + hp) * AT_IMP_STRIDE);
    const float* impA = (const float*)(lds + AT_FIN + (tt * 2) * AT_IMP_STRIDE);
    const float* impB = (const float*)(lds + AT_FIN + (tt * 2 + 1) * AT_IMP_STRIDE);
    unsigned* selm = (unsigned*)(lds + AT_SELM + tt * 256);
    bf16x8 Q[2][2];
#pragma unroll
    for (int h = 0; h < 2; ++h)
#pragma unroll
        for (int ds = 0; ds < 2; ++ds) Q[h][ds] = *(const bf16x8*)(P.Q + (rowbase + tpos) * 512 + (g * 4 + 2 * hp + h) * 64 + 32 * ds + 8 * fq);
    const float mq = wave_max(fabsf(P.qn[lane]));
    const float c0 = -(8.0f * mq * wave_max(fabsf(P.kn[lane])) * 1.03f * 1.4426950408889634f + 0.1f);
    const float c1 = -(8.0f * mq * wave_max(fabsf(P.kn[64 + lane])) * 1.03f * 1.4426950408889634f + 0.1f);
    const float c2 = -(8.0f * mq * wave_max(fabsf(P.kn[128 + lane])) * 1.03f * 1.4426950408889634f + 0.1f);
    f32x4 O[2][4]; float l[2], inv[2] = {0.f, 0.f}; float prev = 0.f; unsigned long long sel_lo = 0ull, sel_hi = 0ull;
#define ZERO_O() do { _Pragma("unroll") for (int h = 0; h < 2; ++h) { l[h] = 0.f; _Pragma("unroll") for (int dt = 0; dt < 4; ++dt) O[h][dt] = (f32x4){0.f, 0.f, 0.f, 0.f}; } } while (0)
#define REDUCE_L() do { _Pragma("unroll") for (int h = 0; h < 2; ++h) { l[h] += __shfl_xor(l[h], 16); l[h] += __shfl_xor(l[h], 32); } } while (0)
    const bf16_t* KCg = P.KC + (size_t)b * 512 * 128 + g * 64;
    const bf16_t* VCTg = P.VCT + (size_t)(b * 2 + g) * 64 * 512;
    const int nlim = (tpos >= 31) ? ((tpos - 31) >> 4) : -1;
    const int ncs = (4 * c + 3 + 63) >> 6;
    for (int i = lane; i < 16 * 129; i += 64) imp[i] = 0.f;
    ZERO_O();
    attn_stream<0, false>(lds, KCg, VCTg, 512, 0, ncs, tid, lane, Q, O, l, c0, 0, (unsigned)(nlim + 1), sel_lo, sel_hi, tpos, inv, imp, prev);
    REDUCE_L();
#pragma unroll
    for (int h = 0; h < 2; ++h) inv[h] = l[h] > 0.f ? 1.0f / l[h] : 0.f;
    attn_stream<1, false>(lds, KCg, VCTg, 512, 0, ncs, tid, lane, Q, O, l, c0, 0, (unsigned)(nlim + 1), sel_lo, sel_hi, tpos, inv, imp, prev);
    const unsigned long long ltmask = (1ull << lane) - 1ull;
    for (int tk = 8 * hp; tk < 8 * hp + 8; ++tk) {
        const int cur = (t0 + tk) >> 6;
        const float v0 = impA[tk * 129 + lane] + impB[tk * 129 + lane], v1 = impA[tk * 129 + 64 + lane] + impB[tk * 129 + 64 + lane];
        const unsigned k0 = (lane > cur) ? 0u : ((lane == 0 || lane == cur) ? 0x461C4000u : __builtin_bit_cast(unsigned, v0));
        const unsigned k1 = (lane + 64 > cur) ? 0u : ((lane + 64 == cur) ? 0x461C4000u : __builtin_bit_cast(unsigned, v1));
        unsigned T = 0u;
        for (int bit = 30; bit >= 0; --bit) { const unsigned cand = T | (1u << bit);
            const int cntc = __popcll(__ballot(k0 >= cand)) + __popcll(__ballot(k1 >= cand)); if (cntc >= 16) T = cand; }
        const unsigned long long bg0 = __ballot(k0 > T), bg1 = __ballot(k1 > T);
        const int need = 16 - __popcll(bg0) - __popcll(bg1);
        const unsigned long long be0 = __ballot(k0 == T), be1 = __ballot(k1 == T);
        const int r0 = __popcll(be0 & ltmask), r1 = __popcll(be0) + __popcll(be1 & ltmask);
        const bool s0 = (k0 > T) || ((k0 == T) && r0 < need), s1 = (k1 > T) || ((k1 == T) && r1 < need);
        const unsigned long long m0 = __ballot(s0), m1 = __ballot(s1);
        if (lane == 0) { selm[tk * 4 + 0] = (unsigned)m0; selm[tk * 4 + 1] = (unsigned)(m0 >> 32); selm[tk * 4 + 2] = (unsigned)m1; selm[tk * 4 + 3] = (unsigned)(m1 >> 32); }
    }
    __syncthreads();
    sel_lo = (unsigned long long)selm[fr * 4 + 0] | ((unsigned long long)selm[fr * 4 + 1] << 32);
    sel_hi = (unsigned long long)selm[fr * 4 + 2] | ((unsigned long long)selm[fr * 4 + 3] << 32);
    int tpos_l = tpos; asm volatile("" : "+v"(tpos_l));
#define GATE(h, br) (1.0f / (1.0f + __expf(-bf2f(P.PROJ[(rowbase + tpos_l) * PINP + 1280 + g * 12 + hp * 6 + (h) * 3 + (br)]))))
#pragma unroll
    for (int h = 0; h < 2; ++h)
#pragma unroll
        for (int dt = 0; dt < 4; ++dt) fin[(h * 4 + dt) * 64 + lane] = O[h][dt] * GATE(h, 0);
    ZERO_O();
    attn_stream<2, true>(lds, P.KS + rowbase * 128 + g * 64, P.VST + (size_t)(b * 2 + g) * 64 * SEQ, SEQ, 0, c + 1, tid, lane, Q, O, l, c1, 0, 0u, sel_lo, sel_hi, tpos, inv, imp, prev);
    REDUCE_L();
#pragma unroll
    for (int h = 0; h < 2; ++h) { const float sc = GATE(h, 1) / l[h];
#pragma unroll
        for (int dt = 0; dt < 4; ++dt) fin[(h * 4 + dt) * 64 + lane] += O[h][dt] * sc; }
    ZERO_O();
    { int kbeg = 64 * c - 512; kbeg = kbeg < 0 ? 0 : kbeg;
      attn_stream<2, false>(lds, P.KW + rowbase * 128 + g * 64, P.VWT + (size_t)(b * 2 + g) * 64 * SEQ, SEQ, kbeg, (64 * c + 64 - kbeg) >> 6, tid, lane, Q, O, l, c2, tpos - 511, 512u, sel_lo, sel_hi, tpos, inv, imp, prev); }
    REDUCE_L();
    int lane_l = lane; asm volatile("" : "+v"(lane_l), "+v"(tpos_l));
    bf16_t* op = P.AO + (rowbase + tpos_l) * DM + g * 256 + hp * 128 + 4 * (lane_l >> 4);
#pragma unroll
    for (int h = 0; h < 2; ++h) { const float sc = GATE(h, 2) / l[h];
#pragma unroll
        for (int dt = 0; dt < 4; ++dt) { const f32x4 v = fin[(h * 4 + dt) * 64 + lane] + O[h][dt] * sc;
            u32x2 w; w.x = cvt_pk_bf16(v[0], v[1]); w.y = cvt_pk_bf16(v[2], v[3]); *(u32x2*)(op + h * 64 + 16 * dt) = w; } }
    __syncthreads();
#undef ZERO_O
#undef REDUCE_L
#undef GATE
}

__device__ __forceinline__ void pool_tile(const Args& a, unsigned char* ws, unsigned char* lds, int tile, const int tid) {
    const bf16_t* X = (const bf16_t*)(ws + WS_XB); bf16_t* PD = (bf16_t*)(ws + WS_AO); const float* SS = (const float*)(ws + WS_SS);
    const int row0 = tile * 64, tpos0 = row0 & (SEQ - 1);
    float* rs = (float*)lds;
    if (tid < 80) rs[tid] = (tpos0 - 16 + tid >= 0) ? pg8::rstd_of(SS, row0 - 16 + tid) : 0.f;
    __syncthreads();
    const int c = 2 * tid, win = 2 << (c >> 8);
    const f32x2 gn = *(const f32x2*)(a.in[6] + DM + c);
    f32x2 xo[16], xn[16];
#pragma unroll
    for (int j = 0; j < 16; ++j) { const unsigned xw = (tpos0 - 16 + j >= 0) ? *(const unsigned*)(X + (size_t)(row0 - 16 + j) * DM + c) : 0u; xo[j] = (f32x2){bflo(xw), bfhi(xw)} * rs[j]; }
#pragma unroll 1
    for (int sub = 0; sub < 4; ++sub) {
#pragma unroll
        for (int j = 0; j < 16; ++j) { const unsigned xw = *(const unsigned*)(X + (size_t)(row0 + 16 * sub + j) * DM + c); xn[j] = (f32x2){bflo(xw), bfhi(xw)} * rs[16 + 16 * sub + j]; }
#define PX(k) ((k) >= 0 ? xn[(k) >= 0 ? (k) : 0] : xo[(k) >= 0 ? 0 : 16 + (k)])
#pragma unroll
        for (int t = 0; t < 16; ++t) {
            f32x2 sm = xn[t] + PX(t - 1);
            if (win >= 4) sm += PX(t - 2) + PX(t - 3);
            if (win >= 8) sm += (PX(t - 4) + PX(t - 5)) + (PX(t - 6) + PX(t - 7));
            if (win >= 16) sm += ((PX(t - 8) + PX(t - 9)) + (PX(t - 10) + PX(t - 11))) + ((PX(t - 12) + PX(t - 13)) + (PX(t - 14) + PX(t - 15)));
            const int cn = min(tpos0 + 16 * sub + t + 1, win); const float ic = 1.0f / (float)cn;
            const f32x2 o = gn * (sm * ic - xn[t]);
            *(unsigned*)(PD + (size_t)(row0 + 16 * sub + t) * DM + c) = pk2(o.x, o.y);
        }
#undef PX
#pragma unroll
        for (int j = 0; j < 16; ++j) xo[j] = xn[j];
    }
    __syncthreads();
}

#define XB_TMO      128
#define XB_XCNT(j)  (256  + 64 * (j))
#define XB_XSUB(j)  (1280 + 64 * (j))
#define XB_XGEN(j)  (2304 + 64 * (j))
#define XB_TOP      3328
#define XB_TOPGEN   3392
#define XCD_BAR_WORDS 3456
#define XB_SPIN_CAP (1u << 18)
__device__ __forceinline__ unsigned xb_ld(unsigned* p)              { return __hip_atomic_load(p, __ATOMIC_RELAXED, __HIP_MEMORY_SCOPE_AGENT); }
__device__ __forceinline__ unsigned xb_add(unsigned* p, unsigned v) { return __hip_atomic_fetch_add(p, v, __ATOMIC_RELAXED, __HIP_MEMORY_SCOPE_AGENT); }
__device__ __forceinline__ unsigned xb_xcc_id() { return (unsigned)__builtin_amdgcn_s_getreg((3 << 11) | 20) & 0xFu; }
#define XB_SPIN(cond, bar) do { unsigned _sp = 0; while (cond) { __builtin_amdgcn_s_sleep(1); \
    if ((++_sp & 255u) == 0u) { if (xb_ld(&(bar)[XB_TMO])) break; if (_sp > XB_SPIN_CAP) { atomicAdd(&(bar)[XB_TMO], 1u); break; } } } } while (0)
struct XcdBarrier { unsigned* bar; unsigned x; volatile unsigned* st; };
__device__ __forceinline__ void xcd_barrier_complete(unsigned* bar, unsigned x, unsigned& nloc, unsigned& nx) {
    const unsigned G = gridDim.x * gridDim.y * gridDim.z;
    unsigned sum, cnt, mine, sp = 0u;
    for (;;) {
        sum = 0u; cnt = 0u; mine = 0u;
#pragma unroll
        for (unsigned j = 0; j < 16; ++j) { const unsigned c = xb_ld(&bar[XB_XCNT(j)]); sum += c; cnt += (c > 0u) ? 1u : 0u; mine = (j == x) ? c : mine; }
        if (sum == G) break;
        __builtin_amdgcn_s_sleep(1);
        if ((++sp & 255u) == 0u) { if (xb_ld(&bar[XB_TMO])) break; if (sp > XB_SPIN_CAP) { atomicAdd(&bar[XB_TMO], 1u); break; } }
    }
    nloc = mine > 0u ? mine : 1u; nx = cnt > 0u ? cnt : 1u;
}
__device__ __forceinline__ void xcd_barrier(const XcdBarrier& b, const int tid) {
    asm volatile("s_waitcnt vmcnt(0) lgkmcnt(0)" ::: "memory");
    __syncthreads();
    if (tid == 0) {
        unsigned* bar = b.bar;
        __builtin_amdgcn_s_waitcnt(0);
        unsigned nloc = b.st[0], nx = b.st[1];
        if (nloc == 0u) { xcd_barrier_complete(bar, b.x, nloc, nx); b.st[0] = nloc; b.st[1] = nx; }
        const unsigned old = xb_add(&bar[XB_XSUB(b.x)], 1u);
        const unsigned gen = old / nloc;
        if (old + 1u == (gen + 1u) * nloc) {
            __builtin_amdgcn_fence(__ATOMIC_RELEASE, "agent");
            asm volatile("s_waitcnt vmcnt(0)" ::: "memory");
            const unsigned og = xb_add(&bar[XB_TOP], 1u);
            const unsigned tg = og / nx;
            if (og + 1u == (tg + 1u) * nx) xb_add(&bar[XB_TOPGEN], 1u);
            else XB_SPIN(xb_ld(&bar[XB_TOPGEN]) == tg, bar);
            __builtin_amdgcn_fence(__ATOMIC_ACQUIRE, "agent");
            xb_add(&bar[XB_XGEN(b.x)], 1u);
            asm volatile("s_waitcnt vmcnt(0)" ::: "memory");
        } else {
            XB_SPIN(xb_ld(&bar[XB_XGEN(b.x)]) == gen, bar);
            __builtin_amdgcn_fence(__ATOMIC_ACQUIRE, "agent");
            asm volatile("s_waitcnt vmcnt(0)" ::: "memory");
        }
    }
    __syncthreads();
}

__global__ void __launch_bounds__(512, 2) mega_fwd(Args a) {
    extern __shared__ __attribute__((aligned(16))) unsigned char lds[];
    cg::grid_group grid = cg::this_grid();
    const int G = gridDim.x;
    XcdBarrier xbar; xbar.bar = (unsigned*)a.ws; xbar.x = xb_xcc_id(); xbar.st = (volatile unsigned*)(lds + LDS_ST_OFF);
    if (threadIdx.x < 2) xbar.st[threadIdx.x] = 0u;
    if (blockIdx.x == 0) for (int i = threadIdx.x; i < XCD_BAR_WORDS; i += 512) __hip_atomic_store(&xbar.bar[i], 0u, __ATOMIC_RELAXED, __HIP_MEMORY_SCOPE_AGENT);
    asm volatile("s_waitcnt vmcnt(0) lgkmcnt(0)" ::: "memory");
    grid.sync();
    if (threadIdx.x == 0) (void)xb_add(&xbar.bar[XB_XCNT(xbar.x)], 1u);
#pragma unroll 1
    for (int ph = 0; ph < NPH_RUN; ++ph) {
        int tid = threadIdx.x; asm volatile("" : "+v"(tid));
        int bid = blockIdx.x; asm volatile("" : "+s"(bid));
        size_t ws_o = 0; asm volatile("" : "+s"(ws_o));
        unsigned char* ws = a.ws + ws_o;
        const int wave = __builtin_amdgcn_readfirstlane(tid >> 6), lane = tid & 63;
        bf16_t* XB = (bf16_t*)(ws + WS_XB); float* SS = (float*)(ws + WS_SS); bf16_t* R1 = (bf16_t*)(ws + WS_R1); bf16_t* AO = (bf16_t*)(ws + WS_AO);
        if (ph == 0) {
            prologue(a, ws, lds, bid, wave, lane, G == 256);
        } else if (ph == 1 || ph == 7 || ph == 9 || ph == 13) {
            const int f = ph == 1 ? 0 : ph == 7 ? 1 : ph == 9 ? 2 : 3;
            pg8::Gemm g{XB, (const bf16_t*)(ws + WS_WGU + (size_t)f * 11 * MiB), MTOK, 2 * DFF, DM, DM, DM, 0};
            pg8::StaticOrder S; S.init(MTOK, 2 * DFF, G, bid);
            pg8::EpiGU E{R1, SS};
            pg8::gemm_phase<pg8::EpiGU>((LAS unsigned char*)lds, g, S, E, tid);
            if (G == 256 && f < 3 && bid >= 128) { float* scr = (float*)(lds + wave * 16640); const int wk = (bid - 128) * 8 + wave;
                if (f == 0) { convert_ffn(a, ws, scr, 0, wk, 1024, lane, 16 * 88, 16 * 88 + 44 * 16); convert_misc(a, ws, scr, wk, 1024, lane); }
                convert_ffn(a, ws, scr, f + 1, wk, 1024, lane); }
        } else if (ph == 2 || ph == 6 || ph == 8 || ph == 10 || ph == 12 || ph == 14) {
            pg8::Gemm g; pg8::EpiRes E;
            if (ph == 6) { g = pg8::Gemm{AO, (const bf16_t*)(ws + WS_WOUT), MTOK, DM, DM, DM, DM, 0}; E = pg8::EpiRes{XB, nullptr, SS, nullptr, 1.0f}; }
            else if (ph == 12) { g = pg8::Gemm{AO, (const bf16_t*)(ws + WS_WP), MTOK, DM, 256, DM, 256, 256}; E = pg8::EpiRes{XB, nullptr, SS, a.in[16], 1.0f}; }
            else { const int f = ph == 2 ? 0 : ph == 8 ? 1 : ph == 10 ? 2 : 3;
                g = pg8::Gemm{R1, (const bf16_t*)(ws + WS_WD + (size_t)f * (11 * MiB / 2)), MTOK, DM, DFF, DFF, DFF, 0};
                E = pg8::EpiRes{XB, ph == 14 ? a.out : nullptr, ph == 14 ? nullptr : SS, nullptr, 0.5f}; }
            pg8::StaticOrder S; S.init(MTOK, DM, G, bid);
            pg8::gemm_phase<pg8::EpiRes>((LAS unsigned char*)lds, g, S, E, tid);
        } else if (ph == 3) {
            pg8::Gemm g{XB, (const bf16_t*)(ws + WS_WIN), MTOK, PINP, DM, DM, DM, 0};
            pg8::StaticOrder S; S.init(MTOK, PINP, G, bid);
            pg8::EpiProj E{R1, SS};
            pg8::gemm_phase<pg8::EpiProj>((LAS unsigned char*)lds, g, S, E, tid);
        } else if (ph == 4) {
            for (int s = bid; s < 256; s += G) { post_tile(a, ws, lds, s, tid); compress_task(a, ws, lds, s, tid); }
        } else if (ph == 5) {
            const unsigned char* mx = (const unsigned char*)a.out;
            AttnPtrs P; P.Q = (const bf16_t*)mx; P.KS = (const bf16_t*)(mx + 16 * MiB); P.KW = (const bf16_t*)(mx + 20 * MiB);
            P.VST = (const bf16_t*)(mx + 24 * MiB); P.VWT = (const bf16_t*)(mx + 28 * MiB);
            P.KC = (const bf16_t*)(ws + WS_MISC + 64 * 1024); P.VCT = (const bf16_t*)(ws + WS_MISC + 512 * 1024); P.PROJ = R1; P.AO = AO;
            P.qn = a.in[8]; P.kn = a.in[9];
            for (int s = bid; s < 256; s += G) {
                const int b = (s >> 1) & 1, gq = s & 1, cp = s >> 2;
                attn_chunk(P, lds, b, gq, cp, tid, wave, lane);
                attn_chunk(P, lds, b, gq, 127 - cp, tid, wave, lane);
            }
        } else if (ph == 11) {
            for (int s = bid; s < 256; s += G) pool_tile(a, ws, lds, s, tid);
        }
        if (ph != NPH_RUN - 1) xcd_barrier(xbar, tid);
    }
}

extern "C" void kernel_launch(void* const* d_in, const int* in_sizes, int n_in, void* d_out, int out_size, void* d_ws, size_t ws_size, hipStream_t stream) {
    static int grid = 0;
    if (grid == 0) {
        int dev = 0, cus = 0, per_cu = 0;
        hipGetDevice(&dev);
        hipDeviceGetAttribute(&cus, hipDeviceAttributeMultiprocessorCount, dev);
        hipFuncSetAttribute((const void*)mega_fwd, hipFuncAttributeMaxDynamicSharedMemorySize, LDS_BYTES);
        hipOccupancyMaxActiveBlocksPerMultiprocessor(&per_cu, (const void*)mega_fwd, 512, LDS_BYTES);
        if (per_cu < 1) { fprintf(stderr, "kernel_launch: occupancy query says %d blocks per CU\n", per_cu); per_cu = 1; }
        if (per_cu > 1) per_cu = 1;
        grid = cus * per_cu;
        if (grid > 256) grid = 256;
    }
    Args a{};
    for (int i = 0; i < 17; ++i) a.in[i] = (const float*)d_in[i];
    a.out = (float*)d_out; a.ws = (unsigned char*)d_ws;
    void* args[] = {&a};
    hipError_t e = hipLaunchCooperativeKernel((const void*)mega_fwd, dim3(grid), dim3(512), args, LDS_BYTES, stream);
    if (e != hipSuccess) fprintf(stderr, "cooperative launch failed: %s (grid %d)\n", hipGetErrorString(e), grid);
}
```

```cpp
#include <hip/hip_runtime.h>
#include <hip/hip_cooperative_groups.h>
#include <cstdio>
#include <cstdint>
namespace cg = cooperative_groups;

#define LAS __attribute__((address_space(3)))
typedef unsigned short bf16_t;
typedef short bf16x8 __attribute__((ext_vector_type(8)));
typedef float f32x4 __attribute__((ext_vector_type(4)));
typedef float f32x2 __attribute__((ext_vector_type(2)));
typedef unsigned u32x4 __attribute__((ext_vector_type(4)));
typedef unsigned u32x2 __attribute__((ext_vector_type(2)));

constexpr int SEQ = 8192, MTOK = 16384, DM = 1024, DFF = 2816, PIN = 2840, PINP = 3072;
constexpr size_t MiB = 1u << 20;
constexpr size_t WS_WGU = 1 * MiB;
constexpr size_t WS_WD = 45 * MiB;
constexpr size_t WS_WIN = 67 * MiB;
constexpr size_t WS_WOUT = 73 * MiB;
constexpr size_t WS_WP = 75 * MiB;
constexpr size_t WS_WC1 = 75 * MiB + 512 * 1024;
constexpr size_t WS_MISC = 77 * MiB;
constexpr size_t WS_SS = 78 * MiB;
constexpr size_t WS_R1 = 80 * MiB;
constexpr size_t WS_XB = 176 * MiB;
constexpr size_t WS_AO = 208 * MiB;
constexpr int LDS_BYTES = 147456;
constexpr int LDS_ST_OFF = LDS_BYTES - 64;
#ifndef NPH_RUN
#define NPH_RUN 15
#endif

__device__ __forceinline__ unsigned f2bf(float f) { unsigned u = __builtin_bit_cast(unsigned, f); return (u + 0x7fffu + ((u >> 16) & 1u)) >> 16; }
typedef float f32x2_t __attribute__((ext_vector_type(2))); typedef __bf16 bf16x2_t __attribute__((ext_vector_type(2)));
__device__ __forceinline__ unsigned cvt_pk_bf16(float lo, float hi) { f32x2_t v = {lo, hi}; bf16x2_t b = __builtin_convertvector(v, bf16x2_t); return __builtin_bit_cast(unsigned, b); }
__device__ __forceinline__ unsigned pk2(float lo, float hi) { return cvt_pk_bf16(lo, hi); }
__device__ __forceinline__ float bf2f(unsigned short h) { return __builtin_bit_cast(float, (unsigned)h << 16); }
__device__ __forceinline__ float bflo(unsigned w) { return __builtin_bit_cast(float, w << 16); }
__device__ __forceinline__ float bfhi(unsigned w) { return __builtin_bit_cast(float, w & 0xffff0000u); }
__device__ __forceinline__ f32x4 mfma16(bf16x8 a, bf16x8 b, f32x4 c) { return __builtin_amdgcn_mfma_f32_16x16x32_bf16(a, b, c, 0, 0, 0); }
#define LDS_WAIT() asm volatile("s_waitcnt lgkmcnt(0)" ::: "memory")
__device__ __forceinline__ float wave_sum(float v) {
#pragma unroll
    for (int o = 1; o < 64; o <<= 1) v += __shfl_xor(v, o);
    return v;
}
__device__ __forceinline__ float wave_max(float v) {
#pragma unroll
    for (int o = 1; o < 64; o <<= 1) v = fmaxf(v, __shfl_xor(v, o));
    return v;
}

struct Args { const float* in[17]; float* out; unsigned char* ws; };

namespace pg8 {
constexpr int BM = 256, BK = 64, HALF = 128, HTB = HALF * BK * 2, STAGE_BYTES = 8 * HTB, NXCD = 8, WGM = 8;
__device__ __forceinline__ int lds_byte(int r, int c) { const int st = (r >> 4) * 2 + (c >> 5), rr = r & 15, cc = c & 31, ob = rr * 64 + cc * 2; return st * 1024 + (ob ^ (((ob >> 9) & 1) << 5)); }
__device__ __forceinline__ void stage_rc(int b, int& R, int& C) { const int st = b / 1024, sb = b % 1024, swz = sb ^ (((sb >> 9) & 1) << 5); R = (st >> 1) * 16 + swz / 64; C = (st & 1) * 32 + (swz % 64) / 2; }
__device__ __forceinline__ int perm32(int rho) { const int n = rho >> 4, i = rho & 15; return 8 * (i >> 2) + 4 * n + (i & 3); }
struct Unit { int pm, pn; };
struct Gemm { const bf16_t* A; const bf16_t* Bt; int M, N, K, lda, ldb, a_pn_off; };
struct StaticOrder {
    int nM, nN, nwg, G, c;
    __device__ void init(int M, int N, int G_, int c_) { nM = M / BM; nN = N / BM; nwg = nM * nN; G = G_; c = c_; }
    __device__ bool next(int i, Unit& u) const {
        const long L = (long)i * G + c; if (L >= nwg) return false;
        int wgid = (int)L; { const int q = nwg / NXCD, r = nwg % NXCD, xcd = wgid % NXCD, off = wgid / NXCD; wgid = (xcd < r ? xcd * (q + 1) : r * (q + 1) + (xcd - r) * q) + off; }
        const int nig = WGM * nN, gid = wgid / nig, fm = gid * WGM, gsz = (nM - fm) < WGM ? (nM - fm) : WGM;
        u.pm = fm + ((wgid % nig) % gsz); u.pn = (wgid % nig) / gsz; return true;
    }
};
__device__ __forceinline__ float rstd_of(const float* ss, int row) {
    const f32x4* p = (const f32x4*)(ss + (size_t)row * 16);
    const f32x4 a = (p[0] + p[1]) + (p[2] + p[3]);
    return __builtin_amdgcn_rsqf(((a.x + a.y) + (a.z + a.w)) * (1.0f / 1024.0f) + 1e-6f);
}
constexpr int RS_LDS_OFF = STAGE_BYTES;
constexpr int RS_MAX_UNITS = 6;
struct EpiGU {
    static constexpr bool PERM = true, HAS_RS = true;
    bf16_t* O; const float* ss;
    __device__ __forceinline__ void operator()(const f32x4 (&acc)[2][2][4][2], const Unit& u, int wr, int wc, int fr, int fq, const LAS float* rsT) const {
        const int row0 = u.pm * BM + wr * 64 + fr, col0 = u.pn * 128 + wc * 32 + 8 * fq;
#pragma unroll
        for (int ai = 0; ai < 2; ++ai)
#pragma unroll
            for (int m = 0; m < 4; ++m) {
                const int row = row0 + ai * HALF + m * 16; const float rs = rsT[ai * HALF + wr * 64 + m * 16 + fr];
                float o[8];
#pragma unroll
                for (int n = 0; n < 2; ++n)
#pragma unroll
                    for (int i = 0; i < 4; ++i) { const float g = acc[ai][0][m][n][i] * rs, up = acc[ai][1][m][n][i] * rs;
                        o[n * 4 + i] = g * __builtin_amdgcn_rcpf(1.0f + __builtin_amdgcn_exp2f(-1.4426950408889634f * g)) * up; }
                u32x4 w; w.x = cvt_pk_bf16(o[0], o[1]); w.y = cvt_pk_bf16(o[2], o[3]); w.z = cvt_pk_bf16(o[4], o[5]); w.w = cvt_pk_bf16(o[6], o[7]);
                *(u32x4*)(O + (size_t)row * DFF + col0) = w;
            }
    }
};
struct EpiProj {
    static constexpr bool PERM = true, HAS_RS = true;
    bf16_t* O; const float* ss;
    __device__ __forceinline__ void operator()(const f32x4 (&acc)[2][2][4][2], const Unit& u, int wr, int wc, int fr, int fq, const LAS float* rsT) const {
        const int row0 = u.pm * BM + wr * 64 + fr, col0 = u.pn * BM + wc * 32 + 8 * fq;
#pragma unroll
        for (int ai = 0; ai < 2; ++ai)
#pragma unroll
            for (int m = 0; m < 4; ++m) {
                const int row = row0 + ai * HALF + m * 16; const float rs = rsT[ai * HALF + wr * 64 + m * 16 + fr];
#pragma unroll
                for (int bj = 0; bj < 2; ++bj) { const f32x4 v0 = acc[ai][bj][m][0] * rs, v1 = acc[ai][bj][m][1] * rs;
                    u32x4 w; w.x = cvt_pk_bf16(v0[0], v0[1]); w.y = cvt_pk_bf16(v0[2], v0[3]); w.z = cvt_pk_bf16(v1[0], v1[1]); w.w = cvt_pk_bf16(v1[2], v1[3]);
                    *(u32x4*)(O + (size_t)row * PINP + col0 + bj * HALF) = w; }
            }
    }
};
struct EpiRes {
    static constexpr bool PERM = true, HAS_RS = false;
    bf16_t* xb; float* fout; float* ssw; const float* cs; float alpha;
    __device__ __forceinline__ void operator()(const f32x4 (&acc)[2][2][4][2], const Unit& u, int wr, int wc, int fr, int fq, const LAS float* rsT) const {
        const int row0 = u.pm * BM + wr * 64 + fr, col0 = u.pn * BM + wc * 32 + 8 * fq;
        f32x4 csv[2][2];
#pragma unroll
        for (int bj = 0; bj < 2; ++bj)
#pragma unroll
            for (int n = 0; n < 2; ++n) csv[bj][n] = cs ? *(const f32x4*)(cs + col0 + bj * HALF + 4 * n) * alpha : (f32x4){alpha, alpha, alpha, alpha};
#pragma unroll
        for (int ai = 0; ai < 2; ++ai)
#pragma unroll
            for (int m = 0; m < 4; ++m) {
                const int row = row0 + ai * HALF + m * 16; float part = 0.f;
#pragma unroll
                for (int bj = 0; bj < 2; ++bj) { const size_t off = (size_t)row * DM + col0 + bj * HALF;
                    const u32x4 xw = *(const u32x4*)(xb + off);
                    const f32x4 x0 = (f32x4){bflo(xw.x), bfhi(xw.x), bflo(xw.y), bfhi(xw.y)} + acc[ai][bj][m][0] * csv[bj][0];
                    const f32x4 x1 = (f32x4){bflo(xw.z), bfhi(xw.z), bflo(xw.w), bfhi(xw.w)} + acc[ai][bj][m][1] * csv[bj][1];
                    if (fout) { *(f32x4*)(fout + off) = x0; *(f32x4*)(fout + off + 4) = x1; }
                    else { u32x4 w; w.x = cvt_pk_bf16(x0[0], x0[1]); w.y = cvt_pk_bf16(x0[2], x0[3]); w.z = cvt_pk_bf16(x1[0], x1[1]); w.w = cvt_pk_bf16(x1[2], x1[3]);
                        *(u32x4*)(xb + off) = w;
                        const float r0 = bflo(w.x), r1 = bfhi(w.x), r2 = bflo(w.y), r3 = bfhi(w.y), r4 = bflo(w.z), r5 = bfhi(w.z), r6 = bflo(w.w), r7 = bfhi(w.w);
                        part += ((r0 * r0 + r1 * r1) + (r2 * r2 + r3 * r3)) + ((r4 * r4 + r5 * r5) + (r6 * r6 + r7 * r7)); } }
                if (ssw) { part += __shfl_xor(part, 16); part += __shfl_xor(part, 32); if (fq == 0) ssw[(size_t)row * 16 + u.pn * 4 + wc] = part; }
            }
    }
};

template <class Epi>
__device__ __forceinline__ void gemm_phase(LAS unsigned char* lds, const Gemm g, const StaticOrder& S, const Epi& E, const int tid) {
    const int wid = __builtin_amdgcn_readfirstlane(tid >> 6), lane = tid & 63, wr = wid >> 2, wc = wid & 3, fr = lane & 15, fq = lane >> 4;
    const int K = g.K, nt = K / BK;
    unsigned voffA[2], voffB[2];
#pragma unroll
    for (int i = 0; i < 2; ++i) { int R, C; stage_rc(tid * 16 + i * 8192, R, C); const int Rb = Epi::PERM ? ((R & ~31) + perm32(R & 31)) : R;
        voffA[i] = (unsigned)(R * g.lda + C) * 2u; voffB[i] = (unsigned)(Rb * g.ldb + C) * 2u; }
    const size_t kstep = (size_t)(BK * 2);
    const size_t hstepA = (size_t)HALF * g.lda * 2, hstepB = (size_t)HALF * g.ldb * 2;
    const size_t tstepA = 2 * hstepA, tstepB = 2 * hstepB;
    const unsigned ldsw = (unsigned)wid * 1024u;
    const int aoff = lds_byte(wr * 64 + fr, fq * 8), boff = lds_byte(wc * 32 + fr, fq * 8);
#define PG8_SA(b, h) (((b) * 2 + (h)) * HTB)
#define PG8_SB(b, h) ((4 + (b) * 2 + (h)) * HTB)
#define PG8_STAGE(bufoff, gbase, voff) do { _Pragma("unroll") for (int _i = 0; _i < 2; ++_i) \
        __builtin_amdgcn_global_load_lds((const unsigned*)((const char*)(gbase) + (voff)[_i]), (LAS unsigned*)(lds + (bufoff) + ldsw + _i * 8192), 16, 0, 0); } while (0)
#define PG8_LDA(dst, b, h) do { _Pragma("unroll") for (int m = 0; m < 4; ++m) _Pragma("unroll") for (int k = 0; k < 2; ++k) dst[m][k] = *(const LAS bf16x8*)(lds + PG8_SA(b, h) + aoff + m * 2048 + k * 1024); } while (0)
#define PG8_LDB(dst, b, h) do { _Pragma("unroll") for (int n = 0; n < 2; ++n) _Pragma("unroll") for (int k = 0; k < 2; ++k) dst[n][k] = *(const LAS bf16x8*)(lds + PG8_SB(b, h) + boff + n * 2048 + k * 1024); } while (0)
#define PG8_MMA(ai, bj, At, Bt) do { __builtin_amdgcn_s_setprio(1); _Pragma("unroll") for (int m = 0; m < 4; ++m) _Pragma("unroll") for (int n = 0; n < 2; ++n) _Pragma("unroll") for (int k = 0; k < 2; ++k) \
        acc[ai][bj][m][n] = __builtin_amdgcn_mfma_f32_16x16x32_bf16(Bt[n][k], At[m][k], acc[ai][bj][m][n], 0, 0, 0); __builtin_amdgcn_s_setprio(0); } while (0)
#define PG8_WAIT_V(n) asm volatile("s_waitcnt vmcnt(" #n ")" ::: "memory")
#define PG8_WAIT_L(n) asm volatile("s_waitcnt lgkmcnt(" #n ")" ::: "memory")
#define PG8_BAR __builtin_amdgcn_s_barrier()
#define PG8_SCHED __builtin_amdgcn_sched_barrier(0)
    Unit cur, nxt; int ui = 0;
    if (!S.next(0, cur)) return;
    if constexpr (Epi::HAS_RS) {
        LAS float* tb = (LAS float*)(lds + RS_LDS_OFF);
        for (int r = tid; r < RS_MAX_UNITS * BM; r += 512) { Unit uu; if (S.next(r >> 8, uu)) tb[r] = rstd_of(E.ss, uu.pm * BM + (r & 255)); }
        __syncthreads();
    }
    f32x4 acc[2][2][4][2];
#pragma unroll
    for (int a = 0; a < 2; ++a)
#pragma unroll
        for (int b = 0; b < 2; ++b)
#pragma unroll
            for (int m = 0; m < 4; ++m)
#pragma unroll
                for (int n = 0; n < 2; ++n) acc[a][b][m][n] = (f32x4){0.f, 0.f, 0.f, 0.f};
    bf16x8 At[4][2], B0[2][2], B1[2][2];
    const char* cA = (const char*)g.A + (size_t)cur.pm * tstepA + (size_t)cur.pn * g.a_pn_off * 2; const char* cB = (const char*)g.Bt + (size_t)cur.pn * tstepB;
    PG8_STAGE(PG8_SB(0, 0), cB, voffB); PG8_STAGE(PG8_SB(0, 1), cB + hstepB, voffB); PG8_STAGE(PG8_SA(0, 0), cA, voffA); PG8_STAGE(PG8_SA(0, 1), cA + hstepA, voffA);
    if (wr == 1) PG8_BAR;
    PG8_WAIT_V(2); PG8_BAR;
    PG8_STAGE(PG8_SB(1, 0), cB + kstep, voffB); PG8_STAGE(PG8_SA(1, 0), cA + kstep, voffA); PG8_STAGE(PG8_SB(1, 1), cB + hstepB + kstep, voffB);
    PG8_WAIT_V(6); PG8_BAR;
    for (;;) {
        const bool has_next = S.next(ui + 1, nxt);
        const char* nA = has_next ? (const char*)g.A + (size_t)nxt.pm * tstepA + (size_t)nxt.pn * g.a_pn_off * 2 : cA; const char* nB = has_next ? (const char*)g.Bt + (size_t)nxt.pn * tstepB : cB;
        for (int t = 0; t < nt; t += 2) {
            const bool last = (t == nt - 2);
            const char* a1 = cA + (size_t)(t + 1) * kstep;
            const char* a2 = last ? nA : cA + (size_t)(t + 2) * kstep; const char* b2 = last ? nB : cB + (size_t)(t + 2) * kstep;
            const char* a3 = a2 + kstep; const char* b3 = b2 + kstep;
            PG8_LDB(B0, 0, 0); PG8_LDB(B1, 0, 1); PG8_SCHED; PG8_LDA(At, 0, 0); PG8_STAGE(PG8_SA(1, 1), a1 + hstepA, voffA);
            PG8_WAIT_V(8); PG8_WAIT_L(0); PG8_BAR; PG8_MMA(0, 0, At, B0); PG8_MMA(0, 1, At, B1); PG8_BAR; PG8_SCHED;
            PG8_LDA(At, 0, 1); PG8_STAGE(PG8_SB(0, 0), b2, voffB); PG8_STAGE(PG8_SB(0, 1), b2 + hstepB, voffB); PG8_STAGE(PG8_SA(0, 0), a2, voffA);
            PG8_WAIT_V(8); PG8_WAIT_L(0); PG8_BAR; PG8_MMA(1, 0, At, B0); PG8_MMA(1, 1, At, B1); PG8_BAR; PG8_SCHED;
            PG8_LDB(B0, 1, 0); PG8_LDB(B1, 1, 1); PG8_SCHED; PG8_LDA(At, 1, 0); PG8_STAGE(PG8_SA(0, 1), a2 + hstepA, voffA);
            PG8_WAIT_V(8); PG8_WAIT_L(0); PG8_BAR; PG8_MMA(0, 0, At, B0); PG8_MMA(0, 1, At, B1); PG8_BAR; PG8_SCHED;
            PG8_LDA(At, 1, 1); PG8_STAGE(PG8_SB(1, 0), b3, voffB); PG8_STAGE(PG8_SB(1, 1), b3 + hstepB, voffB); PG8_STAGE(PG8_SA(1, 0), a3, voffA);
            PG8_WAIT_V(8); PG8_WAIT_L(0); PG8_BAR; PG8_MMA(1, 0, At, B0); PG8_MMA(1, 1, At, B1); PG8_BAR; PG8_SCHED;
        }
        if (wr == 0) PG8_BAR;
        E(acc, cur, wr, wc, fr, fq, (const LAS float*)(lds + RS_LDS_OFF) + ui * BM);
        if (!has_next) break;
#pragma unroll
        for (int a = 0; a < 2; ++a)
#pragma unroll
            for (int b = 0; b < 2; ++b)
#pragma unroll
                for (int m = 0; m < 4; ++m)
#pragma unroll
                    for (int n = 0; n < 2; ++n) acc[a][b][m][n] = (f32x4){0.f, 0.f, 0.f, 0.f};
        cur = nxt; cA = nA; cB = nB; ++ui;
        if (wr == 1) PG8_BAR;
    }
    PG8_WAIT_V(0);
    PG8_BAR;
#undef PG8_SA
#undef PG8_SB
#undef PG8_STAGE
#undef PG8_LDA
#undef PG8_LDB
#undef PG8_MMA
#undef PG8_WAIT_V
#undef PG8_WAIT_L
#undef PG8_BAR
#undef PG8_SCHED
}
}

__device__ __forceinline__ void tr_item(const float* __restrict__ W, int ldw, int nvalid, int k0, int n0, bf16_t* WT, int ldk, int drow0,
                                        const float* gain, float* scr, int lane) {
    const int r = lane >> 4, c4 = (lane & 15) * 4;
    f32x4 v[16];
    const bool ok = (n0 + c4) < nvalid;
#pragma unroll
    for (int i = 0; i < 16; ++i) v[i] = ok ? *(const f32x4*)(W + (size_t)(k0 + 4 * i + r) * ldw + n0 + c4) : (f32x4){0.f, 0.f, 0.f, 0.f};
#pragma unroll
    for (int i = 0; i < 16; ++i) { const int kk = 4 * i + r; const float gm = gain ? gain[k0 + kk] : 1.0f; float* d = scr + kk * 65 + c4;
        d[0] = v[i].x * gm; d[1] = v[i].y * gm; d[2] = v[i].z * gm; d[3] = v[i].w * gm; }
    LDS_WAIT();
    const int c = lane & 7;
#pragma unroll
    for (int j = 0; j < 8; ++j) { const int n = (lane >> 3) + 8 * j; const float* p = scr + (8 * c) * 65 + n;
        u32x4 o; o.x = pk2(p[0 * 65], p[1 * 65]); o.y = pk2(p[2 * 65], p[3 * 65]); o.z = pk2(p[4 * 65], p[5 * 65]); o.w = pk2(p[6 * 65], p[7 * 65]);
        *(u32x4*)(WT + (size_t)(drow0 + n) * ldk + k0 + 8 * c) = o; }
    LDS_WAIT();
}

__device__ __forceinline__ void convert_ffn(const Args& a, unsigned char* ws, float* scr, int f, int wk, int nw, int lane, int lo_item = 0, int hi_item = 16 * 88 + 44 * 16) {
    constexpr int I_GU = 16 * 88, I_D = 44 * 16;
    for (int it = lo_item + wk; it < hi_item; it += nw) {
        int r = it;
        if (r < I_GU) { const int kb = r / 88, nb = r % 88, which = nb / 44, n0 = 64 * (nb % 44);
            const float* W = (which ? a.in[4] : a.in[3]) + (size_t)f * DM * DFF;
            tr_item(W, DFF, DFF, 64 * kb, n0, (bf16_t*)(ws + WS_WGU + (size_t)f * 11 * MiB), DM, 256 * (n0 >> 7) + 128 * which + (n0 & 127), a.in[2] + f * DM, scr, lane); continue; }
        r -= I_GU;
        { const int kb = r / 16, nb = r % 16;
            tr_item(a.in[5] + (size_t)f * DFF * DM, DM, DM, 64 * kb, 64 * nb, (bf16_t*)(ws + WS_WD + (size_t)f * (11 * MiB / 2)), DFF, 64 * nb, nullptr, scr, lane); }
    }
}

__device__ __forceinline__ void convert_misc(const Args& a, unsigned char* ws, float* scr, int wk, int nw, int lane) {
    constexpr int I_IN = 16 * 48, I_OUT = 16 * 16, I_P = 64, I_C = 128;
    constexpr int NITEMS = I_IN + I_OUT + I_P + I_C;
    for (int it = wk; it < NITEMS; it += nw) {
        int r = it;
        if (r < I_IN) { const int kb = r / 48, nb = r % 48;
            tr_item(a.in[7], PIN, PIN, 64 * kb, 64 * nb, (bf16_t*)(ws + WS_WIN), DM, 64 * nb, a.in[6], scr, lane); continue; }
        r -= I_IN;
        if (r < I_OUT) { const int kb = r / 16, nb = r % 16;
            tr_item(a.in[14], DM, DM, 64 * kb, 64 * nb, (bf16_t*)(ws + WS_WOUT), DM, 64 * nb, nullptr, scr, lane); continue; }
        r -= I_OUT;
        if (r < I_P) { const int gi = r / 16, rr = r % 16, kb = rr / 4, nb = rr % 4;
            tr_item(a.in[15] + (size_t)gi * 65536, 256, 256, 64 * kb, 64 * nb, (bf16_t*)(ws + WS_WP), 256, gi * 256 + 64 * nb, nullptr, scr, lane); continue; }
        r -= I_P;
        { const int kv = r / 64, rr = r % 64, kb = rr / 2, nb = rr % 2;
            tr_item(a.in[11] + (size_t)kv * 2048 * 128, 128, 128, 64 * kb, 64 * nb, (bf16_t*)(ws + WS_WC1), 2048, kv * 128 + 64 * nb, nullptr, scr, lane); }
    }
    if (wk < 256) { const int kv = wk >> 7, j = wk & 127; const float* pos = a.in[10] + kv * 2048; const float* w1 = a.in[11] + (size_t)kv * 2048 * 128;
        float s = 0.f; for (int k = lane; k < 2048; k += 64) s += pos[k] * w1[(size_t)k * 128 + j];
        s = wave_sum(s); if (lane == 0) ((float*)(ws + WS_MISC))[wk] = s; }
}

__device__ __forceinline__ void prologue(const Args& a, unsigned char* ws, unsigned char* lds, int bid, int wave, int lane, bool late) {
    float* scr = (float*)(lds + wave * 16640);
    const int gw = bid * 8 + wave, NGW = gridDim.x * 8;
    if (late) convert_ffn(a, ws, scr, 0, gw, NGW, lane, 0, 16 * 88);
    else for (int f = 0; f < 4; ++f) convert_ffn(a, ws, scr, f, gw, NGW, lane);
    if (!late) convert_misc(a, ws, scr, gw, NGW, lane);
    const float* x = a.in[0]; bf16_t* XB = (bf16_t*)(ws + WS_XB); float* SS = (float*)(ws + WS_SS);
    for (int m = gw; m < MTOK; m += 2 * NGW) {
        f32x4 v[2][4];
#pragma unroll
        for (int q = 0; q < 2; ++q)
#pragma unroll
            for (int j = 0; j < 4; ++j) v[q][j] = (m + q * NGW < MTOK) ? ((const f32x4*)(x + (size_t)(m + q * NGW) * DM) + lane)[64 * j] : (f32x4){0.f, 0.f, 0.f, 0.f};
#pragma unroll
        for (int q = 0; q < 2; ++q) { const int mm = m + q * NGW; if (mm >= MTOK) break; float s = 0.f; u32x2* o8 = (u32x2*)(XB + (size_t)mm * DM) + lane;
#pragma unroll
            for (int j = 0; j < 4; ++j) { const f32x4 t = v[q][j]; s += (t.x * t.x + t.y * t.y) + (t.z * t.z + t.w * t.w);
                u32x2 w; w.x = pk2(t.x, t.y); w.y = pk2(t.z, t.w); o8[64 * j] = w; }
            s = wave_sum(s);
            if (lane < 16) SS[(size_t)mm * 16 + lane] = (lane == 0) ? s : 0.f; }
    }
}

__device__ __forceinline__ void post_tile(const Args& a, unsigned char* ws, unsigned char* lds, int tile, const int tid) {
    const bf16_t* PROJ = (const bf16_t*)(ws + WS_R1);
    unsigned char* mx = (unsigned char*)a.out;
    bf16_t* Qo = (bf16_t*)mx; bf16_t* KS = (bf16_t*)(mx + 16 * MiB); bf16_t* KW = (bf16_t*)(mx + 20 * MiB);
    bf16_t* VST = (bf16_t*)(mx + 24 * MiB); bf16_t* VWT = (bf16_t*)(mx + 28 * MiB); bf16_t* AO = (bf16_t*)(ws + WS_AO);
    const int row0 = tile * 64, b = row0 >> 13, tpos0 = row0 & (SEQ - 1);
    float* cs = (float*)lds; float* sn = cs + 512;
    { const int tl = tid >> 3, i = tid & 7; const float pos = (float)((const int*)a.in[1])[row0 + tl];
      const float freq = powf(500000.0f, -(float)i * 0.125f); float s, c; sincosf(pos * freq, &s, &c); cs[tl * 8 + i] = c; sn[tl * 8 + i] = s; }
    __syncthreads();
    const float qscale = 0.125f * 1.4426950408889634f;
    const int j = tid & 7;
    float gq8[8], gs8[8], gw8[8];
#pragma unroll
    for (int i = 0; i < 8; ++i) { gq8[i] = a.in[8][8 * j + i]; gs8[i] = a.in[9][64 + 8 * j + i]; gw8[i] = a.in[9][128 + 8 * j + i]; }
#pragma unroll 4
    for (int pass = 0; pass < 12; ++pass) {
        const int unit = pass * 64 + (tid >> 3), tl = unit / 12, hu = unit % 12;
        const int col = hu < 8 ? 64 * hu : (hu < 10 ? 768 + 64 * (hu - 8) : 1024 + 64 * (hu - 10));
        const u32x4 raw = *(const u32x4*)(PROJ + (size_t)(row0 + tl) * PINP + col + 8 * j);
        float v[8] = {bflo(raw.x), bfhi(raw.x), bflo(raw.y), bfhi(raw.y), bflo(raw.z), bfhi(raw.z), bflo(raw.w), bfhi(raw.w)};
        float ss = 0.f;
#pragma unroll
        for (int i = 0; i < 8; ++i) ss += v[i] * v[i];
        ss += __shfl_xor(ss, 1); ss += __shfl_xor(ss, 2); ss += __shfl_xor(ss, 4);
        const float rstd = 1.0f / sqrtf(ss * (1.0f / 64.0f) + 1e-6f);
#pragma unroll
        for (int i = 0; i < 8; ++i) v[i] = v[i] * rstd * (hu < 8 ? gq8[i] : (hu < 10 ? gs8[i] : gw8[i]));
#pragma unroll
        for (int i = 0; i < 8; ++i) { const float pr = __shfl_xor(v[i], 1); const float c = cs[tl * 8 + i], s = sn[tl * 8 + i];
            if (j == 0) v[i] = v[i] * c - pr * s; else if (j == 1) v[i] = v[i] * c + pr * s; }
        const float sc = hu < 8 ? qscale : 1.0f;
        u32x4 o; o.x = pk2(v[0] * sc, v[1] * sc); o.y = pk2(v[2] * sc, v[3] * sc); o.z = pk2(v[4] * sc, v[5] * sc); o.w = pk2(v[6] * sc, v[7] * sc);
        bf16_t* dst = hu < 8 ? Qo + (size_t)(row0 + tl) * 512 + 64 * hu : (hu < 10 ? KS + (size_t)(row0 + tl) * 128 + 64 * (hu - 8) : KW + (size_t)(row0 + tl) * 128 + 64 * (hu - 10));
        *(u32x4*)(dst + 8 * j) = o;
    }
    for (int k = 0; k < 4; ++k) { const int u = tid + 512 * k, du = u & 255, tc = u >> 8, src = du >> 6, d = du & 63;
        const int col = (src < 2 ? 896 : 1152) + (src & 1) * 64 + d;
        unsigned short v[8];
#pragma unroll
        for (int i = 0; i < 8; ++i) v[i] = PROJ[(size_t)(row0 + 8 * tc + i) * PINP + col];
        u32x4 o; o.x = v[0] | ((unsigned)v[1] << 16); o.y = v[2] | ((unsigned)v[3] << 16); o.z = v[4] | ((unsigned)v[5] << 16); o.w = v[6] | ((unsigned)v[7] << 16);
        bf16_t* dst = (src < 2 ? VST : VWT) + ((size_t)(b * 2 + (src & 1)) * 64 + d) * SEQ + tpos0 + 8 * tc;
        *(u32x4*)dst = o; }
    { const int c = 2 * (tid & 255), th = tid >> 8; const float* cw = a.in[13];
      const f32x2 w0 = *(const f32x2*)(cw + c), w1 = *(const f32x2*)(cw + 512 + c), w2 = *(const f32x2*)(cw + 1024 + c);
      const int r0 = row0 + 32 * th;
      f32x2 v1 = {0.f, 0.f}, v2 = {0.f, 0.f};
      if (tpos0 + 32 * th > 0) { const bf16_t* p1 = PROJ + (size_t)(r0 - 1) * PINP; const bf16_t* p2 = PROJ + (size_t)(r0 - 2) * PINP;
          const unsigned g1 = *(const unsigned*)(p1 + 2328 + c), u1 = *(const unsigned*)(p1 + 1304 + c), g2 = *(const unsigned*)(p2 + 2328 + c), u2 = *(const unsigned*)(p2 + 1304 + c);
          v1 = (f32x2){bflo(g1) * bflo(u1), bfhi(g1) * bfhi(u1)}; v2 = (f32x2){bflo(g2) * bflo(u2), bfhi(g2) * bfhi(u2)}; }
#pragma unroll 1
      for (int tb = 0; tb < 32; tb += 8) {
          unsigned uu[8], gb[8], gc[8];
#pragma unroll
          for (int i = 0; i < 8; ++i) { const bf16_t* p = PROJ + (size_t)(r0 + tb + i) * PINP; uu[i] = *(const unsigned*)(p + 1304 + c); gb[i] = *(const unsigned*)(p + 1816 + c); gc[i] = *(const unsigned*)(p + 2328 + c); }
#pragma unroll
          for (int i = 0; i < 8; ++i) { const f32x2 v = (f32x2){bflo(gc[i]) * bflo(uu[i]), bfhi(gc[i]) * bfhi(uu[i])};
              const f32x2 y = w2 * v + w1 * v1 + w0 * v2;
              *(unsigned*)(AO + (size_t)(r0 + tb + i) * DM + 512 + c) = pk2(bflo(gb[i]) * y.x, bfhi(gb[i]) * y.y); v2 = v1; v1 = v; } } }
    __syncthreads();
}

__device__ __forceinline__ void compress_task(const Args& a, unsigned char* ws, unsigned char* lds, int task, const int tid) {
    const int wave = tid >> 6, lane = tid & 63, fr = lane & 15, fq = lane >> 4;
    const bf16_t* PROJ = (const bf16_t*)(ws + WS_R1); const bf16_t* WC1 = (const bf16_t*)(ws + WS_WC1);
    const float* bias1 = (const float*)(ws + WS_MISC);
    bf16_t* KC = (bf16_t*)(ws + WS_MISC + 64 * 1024); bf16_t* VCT = (bf16_t*)(ws + WS_MISC + 512 * 1024);
    const int kv = task >> 7, b = (task >> 6) & 1, g = (task >> 5) & 1, n0 = (task & 31) * 16;
    bf16_t* Hs = (bf16_t*)lds;
    float* Os = (float*)(lds + 8192);
    float* Ps = (float*)(lds + 16384);
    {
        f32x4 acc[8];
#pragma unroll
        for (int nt = 0; nt < 8; ++nt) acc[nt] = (f32x4){0.f, 0.f, 0.f, 0.f};
        const bf16_t* ap = PROJ + 512 + kv * 128 + g * 64 + 8 * fq;
        const bf16_t* bp = WC1 + (size_t)(kv * 128 + fr) * 2048 + 256 * wave + 8 * fq;
        const int n = n0 + fr;
#pragma unroll 2
        for (int ks = 0; ks < 8; ++ks) { const int kk = 8 * wave + ks; int tok = 16 * n + (kk >> 1); tok = tok > SEQ - 1 ? SEQ - 1 : tok;
            const bf16x8 af = *(const bf16x8*)(ap + (size_t)(b * SEQ + tok) * PINP + (kk & 1) * 32);
            bf16x8 bfr[8];
#pragma unroll
            for (int nt = 0; nt < 8; ++nt) bfr[nt] = *(const bf16x8*)(bp + (size_t)nt * 16 * 2048 + ks * 32);
#pragma unroll
            for (int nt = 0; nt < 8; ++nt) acc[nt] = mfma16(af, bfr[nt], acc[nt]); }
#pragma unroll
        for (int nt = 0; nt < 8; ++nt)
#pragma unroll
            for (int jj = 0; jj < 4; ++jj) Ps[(wave * 16 + 4 * fq + jj) * 132 + 16 * nt + fr] = acc[nt][jj];
    }
    __syncthreads();
    {
        const int row = tid >> 5, col = (tid & 31) * 4;
        f32x4 sm = {0.f, 0.f, 0.f, 0.f};
#pragma unroll
        for (int w = 0; w < 8; ++w) sm += *(const f32x4*)(Ps + (w * 16 + row) * 132 + col);
        unsigned short hv[4];
#pragma unroll
        for (int i = 0; i < 4; ++i) { const float x = sm[i] + bias1[kv * 128 + col + i]; const float u = 0.7978845608028654f * (x + 0.044715f * x * x * x);
            const float th = 1.0f - 2.0f / (__expf(2.0f * u) + 1.0f); hv[i] = (unsigned short)f2bf(0.5f * x * (1.0f + th)); }
        u32x2 o; o.x = hv[0] | ((unsigned)hv[1] << 16); o.y = hv[2] | ((unsigned)hv[3] << 16);
        *(u32x2*)(Hs + row * 136 + col) = o;
    }
    __syncthreads();
    if (wave < 4) { const int dt = wave; f32x4 acc = {0.f, 0.f, 0.f, 0.f}; const float* w2 = a.in[12] + (size_t)kv * 128 * 64;
#pragma unroll
        for (int kk = 0; kk < 4; ++kk) { const bf16x8 af = *(const bf16x8*)(Hs + fr * 136 + kk * 32 + 8 * fq);
            float wv[8];
#pragma unroll
            for (int i = 0; i < 8; ++i) wv[i] = w2[(size_t)(kk * 32 + 8 * fq + i) * 64 + 16 * dt + fr];
            u32x4 bw; bw.x = pk2(wv[0], wv[1]); bw.y = pk2(wv[2], wv[3]); bw.z = pk2(wv[4], wv[5]); bw.w = pk2(wv[6], wv[7]);
            acc = mfma16(af, __builtin_bit_cast(bf16x8, bw), acc); }
#pragma unroll
        for (int jj = 0; jj < 4; ++jj) Os[(4 * fq + jj) * 65 + 16 * dt + fr] = acc[jj]; }
    __syncthreads();
    if (kv == 0) {
        if (tid < 128) { const int nl = tid >> 3, j = tid & 7, n = n0 + nl; float v[8]; float ss = 0.f;
#pragma unroll
            for (int i = 0; i < 8; ++i) { v[i] = Os[nl * 65 + 8 * j + i]; ss += v[i] * v[i]; }
            ss += __shfl_xor(ss, 1); ss += __shfl_xor(ss, 2); ss += __shfl_xor(ss, 4);
            const float rstd = 1.0f / sqrtf(ss * (1.0f / 64.0f) + 1e-6f);
            int ptok = 16 * n + 31; ptok = ptok > SEQ - 1 ? SEQ - 1 : ptok;
            const float pos = (float)((const int*)a.in[1])[b * SEQ + ptok];
#pragma unroll
            for (int i = 0; i < 8; ++i) v[i] = v[i] * rstd * a.in[9][8 * j + i];
#pragma unroll
            for (int i = 0; i < 8; ++i) { const float pr = __shfl_xor(v[i], 1);
                if (j < 2) { const float freq = powf(500000.0f, -(float)i * 0.125f); float s, c; sincosf(pos * freq, &s, &c);
                    v[i] = (j == 0) ? v[i] * c - pr * s : v[i] * c + pr * s; } }
            u32x4 o; o.x = pk2(v[0], v[1]); o.y = pk2(v[2], v[3]); o.z = pk2(v[4], v[5]); o.w = pk2(v[6], v[7]);
            if (n >= 511) o = (u32x4){0u, 0u, 0u, 0u};
            *(u32x4*)(KC + ((size_t)(b * 512 + n) * 2 + g) * 64 + 8 * j) = o; }
    } else {
        if (tid < 64) { const int d = tid; unsigned w[8];
#pragma unroll
            for (int i = 0; i < 8; ++i) { const float v0 = (n0 + 2 * i >= 511) ? 0.f : Os[(2 * i) * 65 + d], v1 = (n0 + 2 * i + 1 >= 511) ? 0.f : Os[(2 * i + 1) * 65 + d]; w[i] = pk2(v0, v1); }
            u32x4* dst = (u32x4*)(VCT + ((size_t)(b * 2 + g) * 64 + d) * 512 + n0);
            dst[0] = (u32x4){w[0], w[1], w[2], w[3]}; dst[1] = (u32x4){w[4], w[5], w[6], w[7]}; }
    }
    __syncthreads();
}

constexpr int AT_TPS = 2, AT_TILE = 18432, AT_STAGE = AT_TPS * AT_TILE, AT_FIN = 2 * AT_STAGE, AT_IMP_STRIDE = 8256, AT_SELM = AT_FIN + 8 * AT_IMP_STRIDE;
struct AttnPtrs { const bf16_t *Q, *KS, *KW, *VST, *VWT, *KC, *VCT, *PROJ; bf16_t* AO; const float *qn, *kn; };

template <int MODE, bool MASKED>
__device__ __forceinline__ void attn_tile(const unsigned char* buf, int key0, int lane, const bf16x8 (&Q)[2][2], f32x4 (&O)[2][4], float (&l)[2],
                                          float ci, int lo, unsigned cnt, const float (&inv)[2], float* imp, float& prev) {
    const int fr = lane & 15, fq = lane >> 4;
    bf16x8 kf[4][2];
#pragma unroll
    for (int kt = 0; kt < 4; ++kt)
#pragma unroll
        for (int ds = 0; ds < 2; ++ds) kf[kt][ds] = *(const bf16x8*)(buf + (16 * kt + fr) * 144 + 64 * ds + 16 * fq);
    bool vm[16];
    if (MASKED) {
#pragma unroll
        for (int i = 0; i < 16; ++i) vm[i] = (unsigned)(key0 + 16 * (i >> 2) + 4 * fq + (i & 3) - lo) < cnt;
    }
    float w[16];
#pragma unroll
    for (int i = 0; i < 16; ++i) w[i] = 0.f;
    u32x4 pk[2][2];
#pragma unroll
    for (int h = 0; h < 2; ++h) {
        f32x4 sc[4];
#pragma unroll
        for (int kt = 0; kt < 4; ++kt) { f32x4 t = {ci, ci, ci, ci}; t = mfma16(kf[kt][0], Q[h][0], t); sc[kt] = mfma16(kf[kt][1], Q[h][1], t); }
        float p[16];
#pragma unroll
        for (int kt = 0; kt < 4; ++kt)
#pragma unroll
            for (int i = 0; i < 4; ++i) { const float e = __builtin_amdgcn_exp2f(sc[kt][i]); p[4 * kt + i] = MASKED ? (vm[4 * kt + i] ? e : 0.f) : e; }
        if (MODE == 1) {
#pragma unroll
            for (int i = 0; i < 16; ++i) { p[i] *= inv[h]; w[i] += p[i]; }
        } else {
            l[h] += (((p[0] + p[1]) + (p[2] + p[3])) + ((p[4] + p[5]) + (p[6] + p[7]))) + (((p[8] + p[9]) + (p[10] + p[11])) + ((p[12] + p[13]) + (p[14] + p[15])));
        }
        if (MODE >= 1) {
#pragma unroll
            for (int hf = 0; hf < 2; ++hf) { pk[h][hf].x = cvt_pk_bf16(p[8 * hf + 0], p[8 * hf + 1]); pk[h][hf].y = cvt_pk_bf16(p[8 * hf + 2], p[8 * hf + 3]);
                pk[h][hf].z = cvt_pk_bf16(p[8 * hf + 4], p[8 * hf + 5]); pk[h][hf].w = cvt_pk_bf16(p[8 * hf + 6], p[8 * hf + 7]); }
        }
    }
    if (MODE >= 1) {
#pragma unroll
        for (int hf = 0; hf < 2; ++hf) {
            bf16x8 vf[4];
#pragma unroll
            for (int dt = 0; dt < 4; ++dt) { const unsigned char* vp = buf + 9216 + (16 * dt + fr) * 144 + (32 * hf + 4 * fq) * 2;
                const u32x2 a0 = *(const u32x2*)vp, a1 = *(const u32x2*)(vp + 32);
                vf[dt] = __builtin_bit_cast(bf16x8, (u32x4){a0.x, a0.y, a1.x, a1.y}); }
#pragma unroll
            for (int dt = 0; dt < 4; ++dt)
#pragma unroll
                for (int h = 0; h < 2; ++h) O[h][dt] = mfma16(vf[dt], __builtin_bit_cast(bf16x8, pk[h][hf]), O[h][dt]);
        }
    }
    if (MODE == 1) {
#pragma unroll
        for (int kt = 0; kt < 4; ++kt) {
            const float w3 = w[4 * kt + 3], sum4 = (w[4 * kt] + w[4 * kt + 1]) + (w[4 * kt + 2] + w3);
            const float rc = __shfl(w3, (lane + 48) & 63), rp = __shfl(prev, (lane + 48) & 63);
            const float spill = fq ? rc : rp; prev = w3;
            imp[fr * 129 + 4 * ((key0 >> 4) + kt) + fq] = sum4 + spill;
        }
    }
}

template <int MODE, bool FLAGGED>
__device__ __forceinline__ void attn_stream(unsigned char* lds, const bf16_t* __restrict__ Kg, const bf16_t* __restrict__ VTg, int vpitch, int kstart, int nst,
                                            const int tid, const int lane, const bf16x8 (&Q)[2][2], f32x4 (&O)[2][4], float (&l)[2], float cinit,
                                            int lo, unsigned cnt, const unsigned long long sel_lo, const unsigned long long sel_hi, int tpos, const float (&inv)[2], float* imp, float& prev) {
    int tid_o = tid, lane_o = lane; asm volatile("" : "+v"(tid_o), "+v"(lane_o));
    const int lr = tid_o >> 3, lc = tid_o & 7, t0w = tpos - (lane & 15);
    const int nstage = (nst + AT_TPS - 1) / AT_TPS;
    {
#pragma unroll
        for (int u = 0; u < AT_TPS; ++u) if (u < nst) {
            const u32x4 kr = *(const u32x4*)(Kg + (size_t)(kstart + 64 * u + lr) * 128 + 8 * lc), vr = *(const u32x4*)(VTg + (size_t)lr * vpitch + kstart + 64 * u + 8 * lc);
            *(u32x4*)(lds + u * AT_TILE + lr * 144 + 16 * lc) = kr; *(u32x4*)(lds + u * AT_TILE + 9216 + lr * 144 + 16 * lc) = vr; }
    }
    __syncthreads();
    for (int sg = 0; sg < nstage; ++sg) {
#pragma unroll 1
        for (int u = 0; u < AT_TPS; ++u) {
            const int ti = sg * AT_TPS + u, tn = ti + AT_TPS;
            const bool pre = tn < nst;
            u32x4 kr, vr;
            if (pre) { kr = *(const u32x4*)(Kg + (size_t)(kstart + 64 * tn + lr) * 128 + 8 * lc); vr = *(const u32x4*)(VTg + (size_t)lr * vpitch + kstart + 64 * tn + 8 * lc); }
            if (ti < nst) {
                const int key0 = kstart + 64 * ti;
                const unsigned char* buf = lds + (sg & 1) * AT_STAGE + u * AT_TILE;
                if (FLAGGED) {
                    const int j = key0 >> 6; const unsigned long long wsel = (j < 64) ? sel_lo : sel_hi;
                    const bool flag = (wsel >> (j & 63)) & 1ull;
                    if (__ballot(flag) != 0ull) {
                        if (key0 + 63 <= t0w) attn_tile<MODE, false>(buf, key0, lane_o, Q, O, l, flag ? cinit : -30000.0f, 0, 0u, inv, imp, prev);
                        else attn_tile<MODE, true>(buf, key0, lane_o, Q, O, l, cinit, 0, flag ? (unsigned)(tpos + 1) : 0u, inv, imp, prev);
                    }
                } else {
                    const bool allv = ((unsigned)(key0 - lo) < cnt) && ((unsigned)(key0 + 63 - lo) < cnt);
                    if (__ballot(!allv) == 0ull) attn_tile<MODE, false>(buf, key0, lane_o, Q, O, l, cinit, lo, cnt, inv, imp, prev);
                    else attn_tile<MODE, true>(buf, key0, lane_o, Q, O, l, cinit, lo, cnt, inv, imp, prev);
                }
            }
            if (pre) { unsigned char* nb = lds + ((sg + 1) & 1) * AT_STAGE + u * AT_TILE;
                *(u32x4*)(nb + lr * 144 + 16 * lc) = kr; *(u32x4*)(nb + 9216 + lr * 144 + 16 * lc) = vr; }
        }
        __syncthreads();
    }
}

__device__ __forceinline__ void attn_chunk(const AttnPtrs& P, unsigned char* lds, int b, int g, int c, const int tid, int wave, int lane) {
    const int fr = lane & 15, fq = lane >> 4, tt = wave & 3, hp = wave >> 2;
    const int t0 = 64 * c + 16 * tt, tpos = t0 + fr;
    const size_t rowbase = (size_t)b * SEQ;
    f32x4* fin = (f32x4*)(lds + AT_FIN + (tt * 2 + hp) * 8192);
    float* imp = (float*)(lds + AT_FIN + (tt * 2 + hp) * AT_IMP_STRIDE);
    const float* impA = (const float*)(lds + AT_FIN + (tt * 2) * AT_IMP_STRIDE);
    const float* impB = (const float*)(lds + AT_FIN + (tt * 2 + 1) * AT_IMP_STRIDE);
    unsigned* selm = (unsigned*)(lds + AT_SELM + tt * 256);
    bf16x8 Q[2][2];
#pragma unroll
    for (int h = 0; h < 2; ++h)
#pragma unroll
        for (int ds = 0; ds < 2; ++ds) Q[h][ds] = *(const bf16x8*)(P.Q + (rowbase + tpos) * 512 + (g * 4 + 2 * hp + h) * 64 + 32 * ds + 8 * fq);
    const float mq = wave_max(fabsf(P.qn[lane]));
    const float c0 = -(8.0f * mq * wave_max(fabsf(P.kn[lane])) * 1.03f * 1.4426950408889634f + 0.1f);
    const float c1 = -(8.0f * mq * wave_max(fabsf(P.kn[64 + lane])) * 1.03f * 1.4426950408889634f + 0.1f);
    const float c2 = -(8.0f * mq * wave_max(fabsf(P.kn[128 + lane])) * 1.03f * 1.4426950408889634f + 0.1f);
    f32x4 O[2][4]; float l[2], inv[2] = {0.f, 0.f}; float prev = 0.f; unsigned long long sel_lo = 0ull, sel_hi = 0ull;
#define ZERO_O() do { _Pragma("unroll") for (int h = 0; h < 2; ++h) { l[h] = 0.f; _Pragma("unroll") for (int dt = 0; dt < 4; ++dt) O[h][dt] = (f32x4){0.f, 0.f, 0.f, 0.f}; } } while (0)
#define REDUCE_L() do { _Pragma("unroll") for (int h = 0; h < 2; ++h) { l[h] += __shfl_xor(l[h], 16); l[h] += __shfl_xor(l[h], 32); } } while (0)
    const bf16_t* KCg = P.KC + (size_t)b * 512 * 128 + g * 64;
    const bf16_t* VCTg = P.VCT + (size_t)(b * 2 + g) * 64 * 512;
    const int nlim = (tpos >= 31) ? ((tpos - 31) >> 4) : -1;
    const int ncs = (4 * c + 3 + 63) >> 6;
    for (int i = lane; i < 16 * 129; i += 64) imp[i] = 0.f;
    ZERO_O();
    attn_stream<0, false>(lds, KCg, VCTg, 512, 0, ncs, tid, lane, Q, O, l, c0, 0, (unsigned)(nlim + 1), sel_lo, sel_hi, tpos, inv, imp, prev);
    REDUCE_L();
#pragma unroll
    for (int h = 0; h < 2; ++h) inv[h] = l[h] > 0.f ? 1.0f / l[h] : 0.f;
    attn_stream<1, false>(lds, KCg, VCTg, 512, 0, ncs, tid, lane, Q, O, l, c0, 0, (unsigned)(nlim + 1), sel_lo, sel_hi, tpos, inv, imp, prev);
    const unsigned long long ltmask = (1ull << lane) - 1ull;
    for (int tk = 8 * hp; tk < 8 * hp + 8; ++tk) {
        const int cur = (t0 + tk) >> 6;
        const float v0 = impA[tk * 129 + lane] + impB[tk * 129 + lane], v1 = impA[tk * 129 + 64 + lane] + impB[tk * 129 + 64 + lane];
        const unsigned k0 = (lane > cur) ? 0u : ((lane == 0 || lane == cur) ? 0x461C4000u : __builtin_bit_cast(unsigned, v0));
        const unsigned k1 = (lane + 64 > cur) ? 0u : ((lane + 64 == cur) ? 0x461C4000u : __builtin_bit_cast(unsigned, v1));
        unsigned T = 0u;
        for (int bit = 30; bit >= 0; --bit) { const unsigned cand = T | (1u << bit);
            const int cntc = __popcll(__ballot(k0 >= cand)) + __popcll(__ballot(k1 >= cand)); if (cntc >= 16) T = cand; }
        const unsigned long long bg0 = __ballot(k0 > T), bg1 = __ballot(k1 > T);
        const int need = 16 - __popcll(bg0) - __popcll(bg1);
        const unsigned long long be0 = __ballot(k0 == T), be1 = __ballot(k1 == T);
        const int r0 = __popcll(be0 & ltmask), r1 = __popcll(be0) + __popcll(be1 & ltmask);
        const bool s0 = (k0 > T) || ((k0 == T) && r0 < need), s1 = (k1 > T) || ((k1 == T) && r1 < need);
        const unsigned long long m0 = __ballot(s0), m1 = __ballot(s1);
        if (lane == 0) { selm[tk * 4 + 0] = (unsigned)m0; selm[tk * 4 + 1] = (unsigned)(m0 >> 32); selm[tk * 4 + 2] = (unsigned)m1; selm[tk * 4 + 3] = (unsigned)(m1 >> 32); }
    }
    __syncthreads();
    sel_lo = (unsigned long long)selm[fr * 4 + 0] | ((unsigned long long)selm[fr * 4 + 1] << 32);
    sel_hi = (unsigned long long)selm[fr * 4 + 2] | ((unsigned long long)selm[fr * 4 + 3] << 32);
    int tpos_l = tpos; asm volatile("" : "+v"(tpos_l));
#define GATE(h, br) (1.0f / (1.0f + __expf(-bf2f(P.PROJ[(rowbase + tpos_l) * PINP + 1280 + g * 12 + hp * 6 + (h) * 3 + (br)]))))
#pragma unroll
    for (int h = 0; h < 2; ++h)
#pragma unroll
        for (int dt = 0; dt < 4; ++dt) fin[(h * 4 + dt) * 64 + lane] = O[h][dt] * GATE(h, 0);
    ZERO_O();
    attn_stream<2, true>(lds, P.KS + rowbase * 128 + g * 64, P.VST + (size_t)(b * 2 + g) * 64 * SEQ, SEQ, 0, c + 1, tid, lane, Q, O, l, c1, 0, 0u, sel_lo, sel_hi, tpos, inv, imp, prev);
    REDUCE_L();
#pragma unroll
    for (int h = 0; h < 2; ++h) { const float sc = GATE(h, 1) / l[h];
#pragma unroll
        for (int dt = 0; dt < 4; ++dt) fin[(h * 4 + dt) * 64 + lane] += O[h][dt] * sc; }
    ZERO_O();
    { int kbeg = 64 * c - 512; kbeg = kbeg < 0 ? 0 : kbeg;
      attn_stream<2, false>(lds, P.KW + rowbase * 128 + g * 64, P.VWT + (size_t)(b * 2 + g) * 64 * SEQ, SEQ, kbeg, (64 * c + 64 - kbeg) >> 6, tid, lane, Q, O, l, c2, tpos - 511, 512u, sel_lo, sel_hi, tpos, inv, imp, prev); }
    REDUCE_L();
    int lane_l = lane; asm volatile("" : "+v"(lane_l), "+v"(tpos_l));
    bf16_t* op = P.AO + (rowbase + tpos_l) * DM + g * 256 + hp * 128 + 4 * (lane_l >> 4);
#pragma unroll
    for (int h = 0; h < 2; ++h) { const float sc = GATE(h, 2) / l[h];
#pragma unroll
        for (int dt = 0; dt < 4; ++dt) { const f32x4 v = fin[(h * 4 + dt) * 64 + lane] + O[h][dt] * sc;
            u32x2 w; w.x = cvt_pk_bf16(v[0], v[1]); w.y = cvt_pk_bf16(v[2], v[3]); *(u32x2*)(op + h * 64 + 16 * dt) = w; } }
    __syncthreads();
#undef ZERO_O
#undef REDUCE_L
#undef GATE
}

__device__ __forceinline__ void pool_tile(const Args& a, unsigned char* ws, unsigned char* lds, int tile, const int tid) {
    const bf16_t* X = (const bf16_t*)(ws + WS_XB); bf16_t* PD = (bf16_t*)(ws + WS_AO); const float* SS = (const float*)(ws + WS_SS);
    const int row0 = tile * 64, tpos0 = row0 & (SEQ - 1);
    float* rs = (float*)lds;
    if (tid < 80) rs[tid] = (tpos0 - 16 + tid >= 0) ? pg8::rstd_of(SS, row0 - 16 + tid) : 0.f;
    __syncthreads();
    const int c = 2 * tid, win = 2 << (c >> 8);
    const f32x2 gn = *(const f32x2*)(a.in[6] + DM + c);
    f32x2 xo[16], xn[16];
#pragma unroll
    for (int j = 0; j < 16; ++j) { const unsigned xw = (tpos0 - 16 + j >= 0) ? *(const unsigned*)(X + (size_t)(row0 - 16 + j) * DM + c) : 0u; xo[j] = (f32x2){bflo(xw), bfhi(xw)} * rs[j]; }
#pragma unroll 1
    for (int sub = 0; sub < 4; ++sub) {
#pragma unroll
        for (int j = 0; j < 16; ++j) { const unsigned xw = *(const unsigned*)(X + (size_t)(row0 + 16 * sub + j) * DM + c); xn[j] = (f32x2){bflo(xw), bfhi(xw)} * rs[16 + 16 * sub + j]; }
#define PX(k) ((k) >= 0 ? xn[(k) >= 0 ? (k) : 0] : xo[(k) >= 0 ? 0 : 16 + (k)])
#pragma unroll
        for (int t = 0; t < 16; ++t) {
            f32x2 sm = xn[t] + PX(t - 1);
            if (win >= 4) sm += PX(t - 2) + PX(t - 3);
            if (win >= 8) sm += (PX(t - 4) + PX(t - 5)) + (PX(t - 6) + PX(t - 7));
            if (win >= 16) sm += ((PX(t - 8) + PX(t - 9)) + (PX(t - 10) + PX(t - 11))) + ((PX(t - 12) + PX(t - 13)) + (PX(t - 14) + PX(t - 15)));
            const int cn = min(tpos0 + 16 * sub + t + 1, win); const float ic = 1.0f / (float)cn;
            const f32x2 o = gn * (sm * ic - xn[t]);
            *(unsigned*)(PD + (size_t)(row0 + 16 * sub + t) * DM + c) = pk2(o.x, o.y);
        }
#undef PX
#pragma unroll
        for (int j = 0; j < 16; ++j) xo[j] = xn[j];
    }
    __syncthreads();
}

#define XB_TMO      128
#define XB_XCNT(j)  (256  + 64 * (j))
#define XB_XSUB(j)  (1280 + 64 * (j))
#define XB_XGEN(j)  (2304 + 64 * (j))
#define XB_TOP      3328
#define XB_TOPGEN   3392
#define XCD_BAR_WORDS 3456
#define XB_SPIN_CAP (1u << 18)
__device__ __forceinline__ unsigned xb_ld(unsigned* p)              { return __hip_atomic_load(p, __ATOMIC_RELAXED, __HIP_MEMORY_SCOPE_AGENT); }
__device__ __forceinline__ unsigned xb_add(unsigned* p, unsigned v) { return __hip_atomic_fetch_add(p, v, __ATOMIC_RELAXED, __HIP_MEMORY_SCOPE_AGENT); }
__device__ __forceinline__ unsigned xb_xcc_id() { return (unsigned)__builtin_amdgcn_s_getreg((3 << 11) | 20) & 0xFu; }
#define XB_SPIN(cond, bar) do { unsigned _sp = 0; while (cond) { __builtin_amdgcn_s_sleep(1); \
    if ((++_sp & 255u) == 0u) { if (xb_ld(&(bar)[XB_TMO])) break; if (_sp > XB_SPIN_CAP) { atomicAdd(&(bar)[XB_TMO], 1u); break; } } } } while (0)
struct XcdBarrier { unsigned* bar; unsigned x; volatile unsigned* st; };
__device__ __forceinline__ void xcd_barrier_complete(unsigned* bar, unsigned x, unsigned& nloc, unsigned& nx) {
    const unsigned G = gridDim.x * gridDim.y * gridDim.z;
    unsigned sum, cnt, mine, sp = 0u;
    for (;;) {
        sum = 0u; cnt = 0u; mine = 0u;
#pragma unroll
        for (unsigned j = 0; j < 16; ++j) { const unsigned c = xb_ld(&bar[XB_XCNT(j)]); sum += c; cnt += (c > 0u) ? 1u : 0u; mine = (j == x) ? c : mine; }
        if (sum == G) break;
        __builtin_amdgcn_s_sleep(1);
        if ((++sp & 255u) == 0u) { if (xb_ld(&bar[XB_TMO])) break; if (sp > XB_SPIN_CAP) { atomicAdd(&bar[XB_TMO], 1u); break; } }
    }
    nloc = mine > 0u ? mine : 1u; nx = cnt > 0u ? cnt : 1u;
}
__device__ __forceinline__ void xcd_barrier(const XcdBarrier& b, const int tid) {
    asm volatile("s_waitcnt vmcnt(0) lgkmcnt(0)" ::: "memory");
    __syncthreads();
    if (tid == 0) {
        unsigned* bar = b.bar;
        __builtin_amdgcn_s_waitcnt(0);
        unsigned nloc = b.st[0], nx = b.st[1];
        if (nloc == 0u) { xcd_barrier_complete(bar, b.x, nloc, nx); b.st[0] = nloc; b.st[1] = nx; }
        const unsigned old = xb_add(&bar[XB_XSUB(b.x)], 1u);
        const unsigned gen = old / nloc;
        if (old + 1u == (gen + 1u) * nloc) {
            __builtin_amdgcn_fence(__ATOMIC_RELEASE, "agent");
            asm volatile("s_waitcnt vmcnt(0)" ::: "memory");
            const unsigned og = xb_add(&bar[XB_TOP], 1u);
            const unsigned tg = og / nx;
            if (og + 1u == (tg + 1u) * nx) xb_add(&bar[XB_TOPGEN], 1u);
            else XB_SPIN(xb_ld(&bar[XB_TOPGEN]) == tg, bar);
            __builtin_amdgcn_fence(__ATOMIC_ACQUIRE, "agent");
            xb_add(&bar[XB_XGEN(b.x)], 1u);
            asm volatile("s_waitcnt vmcnt(0)" ::: "memory");
        } else {
            XB_SPIN(xb_ld(&bar[XB_XGEN(b.x)]) == gen, bar);
            __builtin_amdgcn_fence(__ATOMIC_ACQUIRE, "agent");
            asm volatile("s_waitcnt vmcnt(0)" ::: "memory");
        }
    }
    __syncthreads();
}

__global__ void __launch_bounds__(512, 2) mega_fwd(Args a) {
    extern __shared__ __attribute__((aligned(16))) unsigned char lds[];
    cg::grid_group grid = cg::this_grid();
    const int G = gridDim.x;
    XcdBarrier xbar; xbar.bar = (unsigned*)a.ws; xbar.x = xb_xcc_id(); xbar.st = (volatile unsigned*)(lds + LDS_ST_OFF);
    if (threadIdx.x < 2) xbar.st[threadIdx.x] = 0u;
    if (blockIdx.x == 0) for (int i = threadIdx.x; i < XCD_BAR_WORDS; i += 512) __hip_atomic_store(&xbar.bar[i], 0u, __ATOMIC_RELAXED, __HIP_MEMORY_SCOPE_AGENT);
    asm volatile("s_waitcnt vmcnt(0) lgkmcnt(0)" ::: "memory");
    grid.sync();
    if (threadIdx.x == 0) (void)xb_add(&xbar.bar[XB_XCNT(xbar.x)], 1u);
#pragma unroll 1
    for (int ph = 0; ph < NPH_RUN; ++ph) {
        int tid = threadIdx.x; asm volatile("" : "+v"(tid));
        int bid = blockIdx.x; asm volatile("" : "+s"(bid));
        size_t ws_o = 0; asm volatile("" : "+s"(ws_o));
        unsigned char* ws = a.ws + ws_o;
        const int wave = __builtin_amdgcn_readfirstlane(tid >> 6), lane = tid & 63;
        bf16_t* XB = (bf16_t*)(ws + WS_XB); float* SS = (float*)(ws + WS_SS); bf16_t* R1 = (bf16_t*)(ws + WS_R1); bf16_t* AO = (bf16_t*)(ws + WS_AO);
        if (ph == 0) {
            prologue(a, ws, lds, bid, wave, lane, G == 256);
        } else if (ph == 1 || ph == 7 || ph == 9 || ph == 13) {
            const int f = ph == 1 ? 0 : ph == 7 ? 1 : ph == 9 ? 2 : 3;
            pg8::Gemm g{XB, (const bf16_t*)(ws + WS_WGU + (size_t)f * 11 * MiB), MTOK, 2 * DFF, DM, DM, DM, 0};
            pg8::StaticOrder S; S.init(MTOK, 2 * DFF, G, bid);
            pg8::EpiGU E{R1, SS};
            pg8::gemm_phase<pg8::EpiGU>((LAS unsigned char*)lds, g, S, E, tid);
            if (G == 256 && f < 3 && bid >= 128) { float* scr = (float*)(lds + wave * 16640); const int wk = (bid - 128) * 8 + wave;
                if (f == 0) { convert_ffn(a, ws, scr, 0, wk, 1024, lane, 16 * 88, 16 * 88 + 44 * 16); convert_misc(a, ws, scr, wk, 1024, lane); }
                convert_ffn(a, ws, scr, f + 1, wk, 1024, lane); }
        } else if (ph == 2 || ph == 6 || ph == 8 || ph == 10 || ph == 12 || ph == 14) {
            pg8::Gemm g; pg8::EpiRes E;
            if (ph == 6) { g = pg8::Gemm{AO, (const bf16_t*)(ws + WS_WOUT), MTOK, DM, DM, DM, DM, 0}; E = pg8::EpiRes{XB, nullptr, SS, nullptr, 1.0f}; }
            else if (ph == 12) { g = pg8::Gemm{AO, (const bf16_t*)(ws + WS_WP), MTOK, DM, 256, DM, 256, 256}; E = pg8::EpiRes{XB, nullptr, SS, a.in[16], 1.0f}; }
            else { const int f = ph == 2 ? 0 : ph == 8 ? 1 : ph == 10 ? 2 : 3;
                g = pg8::Gemm{R1, (const bf16_t*)(ws + WS_WD + (size_t)f * (11 * MiB / 2)), MTOK, DM, DFF, DFF, DFF, 0};
                E = pg8::EpiRes{XB, ph == 14 ? a.out : nullptr, ph == 14 ? nullptr : SS, nullptr, 0.5f}; }
            pg8::StaticOrder S; S.init(MTOK, DM, G, bid);
            pg8::gemm_phase<pg8::EpiRes>((LAS unsigned char*)lds, g, S, E, tid);
        } else if (ph == 3) {
            pg8::Gemm g{XB, (const bf16_t*)(ws + WS_WIN), MTOK, PINP, DM, DM, DM, 0};
            pg8::StaticOrder S; S.init(MTOK, PINP, G, bid);
            pg8::EpiProj E{R1, SS};
            pg8::gemm_phase<pg8::EpiProj>((LAS unsigned char*)lds, g, S, E, tid);
        } else if (ph == 4) {
            for (int s = bid; s < 256; s += G) { post_tile(a, ws, lds, s, tid); compress_task(a, ws, lds, s, tid); }
        } else if (ph == 5) {
            const unsigned char* mx = (const unsigned char*)a.out;
            AttnPtrs P; P.Q = (const bf16_t*)mx; P.KS = (const bf16_t*)(mx + 16 * MiB); P.KW = (const bf16_t*)(mx + 20 * MiB);
            P.VST = (const bf16_t*)(mx + 24 * MiB); P.VWT = (const bf16_t*)(mx + 28 * MiB);
            P.KC = (const bf16_t*)(ws + WS_MISC + 64 * 1024); P.VCT = (const bf16_t*)(ws + WS_MISC + 512 * 1024); P.PROJ = R1; P.AO = AO;
            P.qn = a.in[8]; P.kn = a.in[9];
            for (int s = bid; s < 256; s += G) {
                const int b = (s >> 1) & 1, gq = s & 1, cp = s >> 2;
                attn_chunk(P, lds, b, gq, cp, tid, wave, lane);
                attn_chunk(P, lds, b, gq, 127 - cp, tid, wave, lane);
            }
        } else if (ph == 11) {
            for (int s = bid; s < 256; s += G) pool_tile(a, ws, lds, s, tid);
        }
        if (ph != NPH_RUN - 1) xcd_barrier(xbar, tid);
    }
}

extern "C" void kernel_launch(void* const* d_in, const int* in_sizes, int n_in, void* d_out, int out_size, void* d_ws, size_t ws_size, hipStream_t stream) {
    static int grid = 0;
    if (grid == 0) {
        int dev = 0, cus = 0, per_cu = 0;
        hipGetDevice(&dev);
        hipDeviceGetAttribute(&cus, hipDeviceAttributeMultiprocessorCount, dev);
        hipFuncSetAttribute((const void*)mega_fwd, hipFuncAttributeMaxDynamicSharedMemorySize, LDS_BYTES);
        hipOccupancyMaxActiveBlocksPerMultiprocessor(&per_cu, (const void*)mega_fwd, 512, LDS_BYTES);
        if (per_cu < 1) { fprintf(stderr, "kernel_launch: occupancy query says %d blocks per CU\n", per_cu); per_cu = 1; }
        if (per_cu > 1) per_cu = 1;
        grid = cus * per_cu;
        if (grid > 256) grid = 256;
    }
    Args a{};
    for (int i = 0; i < 17; ++i) a.in[i] = (const float*)d_in[i];
    a.out = (float*)d_out; a.ws = (unsigned char*)d_ws;
    void* args[] = {&a};
    hipError_t e = hipLaunchCooperativeKernel((const void*)mega_fwd, dim3(grid), dim3(512), args, LDS_BYTES, stream);
    if (e != hipSuccess) fprintf(stderr, "cooperative launch failed: %s (grid %d)\n", hipGetErrorString(e), grid);
}
```

```cpp
#include <hip/hip_runtime.h>
#include <hip/hip_cooperative_groups.h>
#include <cstdio>
#include <cstdint>
namespace cg = cooperative_groups;

#define LAS __attribute__((address_space(3)))
typedef unsigned short bf16_t;
typedef short bf16x8 __attribute__((ext_vector_type(8)));
typedef float f32x4 __attribute__((ext_vector_type(4)));
typedef float f32x2 __attribute__((ext_vector_type(2)));
typedef unsigned u32x4 __attribute__((ext_vector_type(4)));
typedef unsigned u32x2 __attribute__((ext_vector_type(2)));

constexpr int SEQ = 8192, MTOK = 16384, DM = 1024, DFF = 2816, PIN = 2840, PINP = 3072;
constexpr size_t MiB = 1u << 20;
constexpr size_t WS_WGU = 1 * MiB;
constexpr size_t WS_WD = 45 * MiB;
constexpr size_t WS_WIN = 67 * MiB;
constexpr size_t WS_WOUT = 73 * MiB;
constexpr size_t WS_WP = 75 * MiB;
constexpr size_t WS_WC1 = 75 * MiB + 512 * 1024;
constexpr size_t WS_MISC = 77 * MiB;
constexpr size_t WS_SS = 78 * MiB;
constexpr size_t WS_R1 = 80 * MiB;
constexpr size_t WS_XB = 176 * MiB;
constexpr size_t WS_AO = 208 * MiB;
constexpr int LDS_BYTES = 147456;
constexpr int LDS_ST_OFF = LDS_BYTES - 64;
#ifndef NPH_RUN
#define NPH_RUN 15
#endif

__device__ __forceinline__ unsigned f2bf(float f) { unsigned u = __builtin_bit_cast(unsigned, f); return (u + 0x7fffu + ((u >> 16) & 1u)) >> 16; }
typedef float f32x2_t __attribute__((ext_vector_type(2))); typedef __bf16 bf16x2_t __attribute__((ext_vector_type(2)));
__device__ __forceinline__ unsigned cvt_pk_bf16(float lo, float hi) { f32x2_t v = {lo, hi}; bf16x2_t b = __builtin_convertvector(v, bf16x2_t); return __builtin_bit_cast(unsigned, b); }
__device__ __forceinline__ unsigned pk2(float lo, float hi) { return cvt_pk_bf16(lo, hi); }
__device__ __forceinline__ float bf2f(unsigned short h) { return __builtin_bit_cast(float, (unsigned)h << 16); }
__device__ __forceinline__ float bflo(unsigned w) { return __builtin_bit_cast(float, w << 16); }
__device__ __forceinline__ float bfhi(unsigned w) { return __builtin_bit_cast(float, w & 0xffff0000u); }
__device__ __forceinline__ f32x4 mfma16(bf16x8 a, bf16x8 b, f32x4 c) { return __builtin_amdgcn_mfma_f32_16x16x32_bf16(a, b, c, 0, 0, 0); }
#define LDS_WAIT() asm volatile("s_waitcnt lgkmcnt(0)" ::: "memory")
__device__ __forceinline__ float wave_sum(float v) {
#pragma unroll
    for (int o = 1; o < 64; o <<= 1) v += __shfl_xor(v, o);
    return v;
}
__device__ __forceinline__ float wave_max(float v) {
#pragma unroll
    for (int o = 1; o < 64; o <<= 1) v = fmaxf(v, __shfl_xor(v, o));
    return v;
}

struct Args { const float* in[17]; float* out; unsigned char* ws; };

namespace pg8 {
constexpr int BM = 256, BK = 64, HALF = 128, HTB = HALF * BK * 2, STAGE_BYTES = 8 * HTB, NXCD = 8, WGM = 8;
__device__ __forceinline__ int lds_byte(int r, int c) { const int st = (r >> 4) * 2 + (c >> 5), rr = r & 15, cc = c & 31, ob = rr * 64 + cc * 2; return st * 1024 + (ob ^ (((ob >> 9) & 1) << 5)); }
__device__ __forceinline__ void stage_rc(int b, int& R, int& C) { const int st = b / 1024, sb = b % 1024, swz = sb ^ (((sb >> 9) & 1) << 5); R = (st >> 1) * 16 + swz / 64; C = (st & 1) * 32 + (swz % 64) / 2; }
__device__ __forceinline__ int perm32(int rho) { const int n = rho >> 4, i = rho & 15; return 8 * (i >> 2) + 4 * n + (i & 3); }
struct Unit { int pm, pn; };
struct Gemm { const bf16_t* A; const bf16_t* Bt; int M, N, K, lda, ldb, a_pn_off; };
struct StaticOrder {
    int nM, nN, nwg, G, c;
    __device__ void init(int M, int N, int G_, int c_) { nM = M / BM; nN = N / BM; nwg = nM * nN; G = G_; c = c_; }
    __device__ bool next(int i, Unit& u) const {
        const long L = (long)i * G + c; if (L >= nwg) return false;
        int wgid = (int)L; { const int q = nwg / NXCD, r = nwg % NXCD, xcd = wgid % NXCD, off = wgid / NXCD; wgid = (xcd < r ? xcd * (q + 1) : r * (q + 1) + (xcd - r) * q) + off; }
        const int nig = WGM * nN, gid = wgid / nig, fm = gid * WGM, gsz = (nM - fm) < WGM ? (nM - fm) : WGM;
        u.pm = fm + ((wgid % nig) % gsz); u.pn = (wgid % nig) / gsz; return true;
    }
};
__device__ __forceinline__ float rstd_of(const float* ss, int row) {
    const f32x4* p = (const f32x4*)(ss + (size_t)row * 16);
    const f32x4 a = (p[0] + p[1]) + (p[2] + p[3]);
    return __builtin_amdgcn_rsqf(((a.x + a.y) + (a.z + a.w)) * (1.0f / 1024.0f) + 1e-6f);
}
constexpr int RS_LDS_OFF = STAGE_BYTES;
constexpr int RS_MAX_UNITS = 6;
struct EpiGU {
    static constexpr bool PERM = true, HAS_RS = true;
    bf16_t* O; const float* ss;
    __device__ __forceinline__ void operator()(const f32x4 (&acc)[2][2][4][2], const Unit& u, int wr, int wc, int fr, int fq, const LAS float* rsT) const {
        const int row0 = u.pm * BM + wr * 64 + fr, col0 = u.pn * 128 + wc * 32 + 8 * fq;
#pragma unroll
        for (int ai = 0; ai < 2; ++ai)
#pragma unroll
            for (int m = 0; m < 4; ++m) {
                const int row = row0 + ai * HALF + m * 16; const float rs = rsT[ai * HALF + wr * 64 + m * 16 + fr];
                float o[8];
#pragma unroll
                for (int n = 0; n < 2; ++n)
#pragma unroll
                    for (int i = 0; i < 4; ++i) { const float g = acc[ai][0][m][n][i] * rs, up = acc[ai][1][m][n][i] * rs;
                        o[n * 4 + i] = g * __builtin_amdgcn_rcpf(1.0f + __builtin_amdgcn_exp2f(-1.4426950408889634f * g)) * up; }
                u32x4 w; w.x = cvt_pk_bf16(o[0], o[1]); w.y = cvt_pk_bf16(o[2], o[3]); w.z = cvt_pk_bf16(o[4], o[5]); w.w = cvt_pk_bf16(o[6], o[7]);
                *(u32x4*)(O + (size_t)row * DFF + col0) = w;
            }
    }
};
struct EpiProj {
    static constexpr bool PERM = true, HAS_RS = true;
    bf16_t* O; const float* ss;
    __device__ __forceinline__ void operator()(const f32x4 (&acc)[2][2][4][2], const Unit& u, int wr, int wc, int fr, int fq, const LAS float* rsT) const {
        const int row0 = u.pm * BM + wr * 64 + fr, col0 = u.pn * BM + wc * 32 + 8 * fq;
#pragma unroll
        for (int ai = 0; ai < 2; ++ai)
#pragma unroll
            for (int m = 0; m < 4; ++m) {
                const int row = row0 + ai * HALF + m * 16; const float rs = rsT[ai * HALF + wr * 64 + m * 16 + fr];
#pragma unroll
                for (int bj = 0; bj < 2; ++bj) { const f32x4 v0 = acc[ai][bj][m][0] * rs, v1 = acc[ai][bj][m][1] * rs;
                    u32x4 w; w.x = cvt_pk_bf16(v0[0], v0[1]); w.y = cvt_pk_bf16(v0[2], v0[3]); w.z = cvt_pk_bf16(v1[0], v1[1]); w.w = cvt_pk_bf16(v1[2], v1[3]);
                    *(u32x4*)(O + (size_t)row * PINP + col0 + bj * HALF) = w; }
            }
    }
};
struct EpiRes {
    static constexpr bool PERM = true, HAS_RS = false;
    bf16_t* xb; float* fout; float* ssw; const float* cs; float alpha;
    __device__ __forceinline__ void operator()(const f32x4 (&acc)[2][2][4][2], const Unit& u, int wr, int wc, int fr, int fq, const LAS float* rsT) const {
        const int row0 = u.pm * BM + wr * 64 + fr, col0 = u.pn * BM + wc * 32 + 8 * fq;
        f32x4 csv[2][2];
#pragma unroll
        for (int bj = 0; bj < 2; ++bj)
#pragma unroll
            for (int n = 0; n < 2; ++n) csv[bj][n] = cs ? *(const f32x4*)(cs + col0 + bj * HALF + 4 * n) * alpha : (f32x4){alpha, alpha, alpha, alpha};
#pragma unroll
        for (int ai = 0; ai < 2; ++ai)
#pragma unroll
            for (int m = 0; m < 4; ++m) {
                const int row = row0 + ai * HALF + m * 16; float part = 0.f;
#pragma unroll
                for (int bj = 0; bj < 2; ++bj) { const size_t off = (size_t)row * DM + col0 + bj * HALF;
                    const u32x4 xw = *(const u32x4*)(xb + off);
                    const f32x4 x0 = (f32x4){bflo(xw.x), bfhi(xw.x), bflo(xw.y), bfhi(xw.y)} + acc[ai][bj][m][0] * csv[bj][0];
                    const f32x4 x1 = (f32x4){bflo(xw.z), bfhi(xw.z), bflo(xw.w), bfhi(xw.w)} + acc[ai][bj][m][1] * csv[bj][1];
                    if (fout) { *(f32x4*)(fout + off) = x0; *(f32x4*)(fout + off + 4) = x1; }
                    else { u32x4 w; w.x = cvt_pk_bf16(x0[0], x0[1]); w.y = cvt_pk_bf16(x0[2], x0[3]); w.z = cvt_pk_bf16(x1[0], x1[1]); w.w = cvt_pk_bf16(x1[2], x1[3]);
                        *(u32x4*)(xb + off) = w;
                        const float r0 = bflo(w.x), r1 = bfhi(w.x), r2 = bflo(w.y), r3 = bfhi(w.y), r4 = bflo(w.z), r5 = bfhi(w.z), r6 = bflo(w.w), r7 = bfhi(w.w);
                        part += ((r0 * r0 + r1 * r1) + (r2 * r2 + r3 * r3)) + ((r4 * r4 + r5 * r5) + (r6 * r6 + r7 * r7)); } }
                if (ssw) { part += __shfl_xor(part, 16); part += __shfl_xor(part, 32); if (fq == 0) ssw[(size_t)row * 16 + u.pn * 4 + wc] = part; }
            }
    }
};

template <class Epi>
__device__ __forceinline__ void gemm_phase(LAS unsigned char* lds, const Gemm g, const StaticOrder& S, const Epi& E, const int tid) {
    const int wid = __builtin_amdgcn_readfirstlane(tid >> 6), lane = tid & 63, wr = wid >> 2, wc = wid & 3, fr = lane & 15, fq = lane >> 4;
    const int K = g.K, nt = K / BK;
    unsigned voffA[2], voffB[2];
#pragma unroll
    for (int i = 0; i < 2; ++i) { int R, C; stage_rc(tid * 16 + i * 8192, R, C); const int Rb = Epi::PERM ? ((R & ~31) + perm32(R & 31)) : R;
        voffA[i] = (unsigned)(R * g.lda + C) * 2u; voffB[i] = (unsigned)(Rb * g.ldb + C) * 2u; }
    const size_t kstep = (size_t)(BK * 2);
    const size_t hstepA = (size_t)HALF * g.lda * 2, hstepB = (size_t)HALF * g.ldb * 2;
    const size_t tstepA = 2 * hstepA, tstepB = 2 * hstepB;
    const unsigned ldsw = (unsigned)wid * 1024u;
    const int aoff = lds_byte(wr * 64 + fr, fq * 8), boff = lds_byte(wc * 32 + fr, fq * 8);
#define PG8_SA(b, h) (((b) * 2 + (h)) * HTB)
#define PG8_SB(b, h) ((4 + (b) * 2 + (h)) * HTB)
#define PG8_STAGE(bufoff, gbase, voff) do { _Pragma("unroll") for (int _i = 0; _i < 2; ++_i) \
        __builtin_amdgcn_global_load_lds((const unsigned*)((const char*)(gbase) + (voff)[_i]), (LAS unsigned*)(lds + (bufoff) + ldsw + _i * 8192), 16, 0, 0); } while (0)
#define PG8_LDA(dst, b, h) do { _Pragma("unroll") for (int m = 0; m < 4; ++m) _Pragma("unroll") for (int k = 0; k < 2; ++k) dst[m][k] = *(const LAS bf16x8*)(lds + PG8_SA(b, h) + aoff + m * 2048 + k * 1024); } while (0)
#define PG8_LDB(dst, b, h) do { _Pragma("unroll") for (int n = 0; n < 2; ++n) _Pragma("unroll") for (int k = 0; k < 2; ++k) dst[n][k] = *(const LAS bf16x8*)(lds + PG8_SB(b, h) + boff + n * 2048 + k * 1024); } while (0)
#define PG8_MMA(ai, bj, At, Bt) do { __builtin_amdgcn_s_setprio(1); _Pragma("unroll") for (int m = 0; m < 4; ++m) _Pragma("unroll") for (int n = 0; n < 2; ++n) _Pragma("unroll") for (int k = 0; k < 2; ++k) \
        acc[ai][bj][m][n] = __builtin_amdgcn_mfma_f32_16x16x32_bf16(Bt[n][k], At[m][k], acc[ai][bj][m][n], 0, 0, 0); __builtin_amdgcn_s_setprio(0); } while (0)
#define PG8_WAIT_V(n) asm volatile("s_waitcnt vmcnt(" #n ")" ::: "memory")
#define PG8_WAIT_L(n) asm volatile("s_waitcnt lgkmcnt(" #n ")" ::: "memory")
#define PG8_BAR __builtin_amdgcn_s_barrier()
#define PG8_SCHED __builtin_amdgcn_sched_barrier(0)
    Unit cur, nxt; int ui = 0;
    if (!S.next(0, cur)) return;
    if constexpr (Epi::HAS_RS) {
        LAS float* tb = (LAS float*)(lds + RS_LDS_OFF);
        for (int r = tid; r < RS_MAX_UNITS * BM; r += 512) { Unit uu; if (S.next(r >> 8, uu)) tb[r] = rstd_of(E.ss, uu.pm * BM + (r & 255)); }
        __syncthreads();
    }
    f32x4 acc[2][2][4][2];
#pragma unroll
    for (int a = 0; a < 2; ++a)
#pragma unroll
        for (int b = 0; b < 2; ++b)
#pragma unroll
            for (int m = 0; m < 4; ++m)
#pragma unroll
                for (int n = 0; n < 2; ++n) acc[a][b][m][n] = (f32x4){0.f, 0.f, 0.f, 0.f};
    bf16x8 At[4][2], B0[2][2], B1[2][2];
    const char* cA = (const char*)g.A + (size_t)cur.pm * tstepA + (size_t)cur.pn * g.a_pn_off * 2; const char* cB = (const char*)g.Bt + (size_t)cur.pn * tstepB;
    PG8_STAGE(PG8_SB(0, 0), cB, voffB); PG8_STAGE(PG8_SB(0, 1), cB + hstepB, voffB); PG8_STAGE(PG8_SA(0, 0), cA, voffA); PG8_STAGE(PG8_SA(0, 1), cA + hstepA, voffA);
    if (wr == 1) PG8_BAR;
    PG8_WAIT_V(2); PG8_BAR;
    PG8_STAGE(PG8_SB(1, 0), cB + kstep, voffB); PG8_STAGE(PG8_SA(1, 0), cA + kstep, voffA); PG8_STAGE(PG8_SB(1, 1), cB + hstepB + kstep, voffB);
    PG8_WAIT_V(6); PG8_BAR;
    for (;;) {
        const bool has_next = S.next(ui + 1, nxt);
        const char* nA = has_next ? (const char*)g.A + (size_t)nxt.pm * tstepA + (size_t)nxt.pn * g.a_pn_off * 2 : cA; const char* nB = has_next ? (const char*)g.Bt + (size_t)nxt.pn * tstepB : cB;
        for (int t = 0; t < nt; t += 2) {
            const bool last = (t == nt - 2);
            const char* a1 = cA + (size_t)(t + 1) * kstep;
            const char* a2 = last ? nA : cA + (size_t)(t + 2) * kstep; const char* b2 = last ? nB : cB + (size_t)(t + 2) * kstep;
            const char* a3 = a2 + kstep; const char* b3 = b2 + kstep;
            PG8_LDB(B0, 0, 0); PG8_LDB(B1, 0, 1); PG8_SCHED; PG8_LDA(At, 0, 0); PG8_STAGE(PG8_SA(1, 1), a1 + hstepA, voffA);
            PG8_WAIT_V(8); PG8_WAIT_L(0); PG8_BAR; PG8_MMA(0, 0, At, B0); PG8_MMA(0, 1, At, B1); PG8_BAR; PG8_SCHED;
            PG8_LDA(At, 0, 1); PG8_STAGE(PG8_SB(0, 0), b2, voffB); PG8_STAGE(PG8_SB(0, 1), b2 + hstepB, voffB); PG8_STAGE(PG8_SA(0, 0), a2, voffA);
            PG8_WAIT_V(8); PG8_WAIT_L(0); PG8_BAR; PG8_MMA(1, 0, At, B0); PG8_MMA(1, 1, At, B1); PG8_BAR; PG8_SCHED;
            PG8_LDB(B0, 1, 0); PG8_LDB(B1, 1, 1); PG8_SCHED; PG8_LDA(At, 1, 0); PG8_STAGE(PG8_SA(0, 1), a2 + hstepA, voffA);
            PG8_WAIT_V(8); PG8_WAIT_L(0); PG8_BAR; PG8_MMA(0, 0, At, B0); PG8_MMA(0, 1, At, B1); PG8_BAR; PG8_SCHED;
            PG8_LDA(At, 1, 1); PG8_STAGE(PG8_SB(1, 0), b3, voffB); PG8_STAGE(PG8_SB(1, 1), b3 + hstepB, voffB); PG8_STAGE(PG8_SA(1, 0), a3, voffA);
            PG8_WAIT_V(8); PG8_WAIT_L(0); PG8_BAR; PG8_MMA(1, 0, At, B0); PG8_MMA(1, 1, At, B1); PG8_BAR; PG8_SCHED;
        }
        if (wr == 0) PG8_BAR;
        E(acc, cur, wr, wc, fr, fq, (const LAS float*)(lds + RS_LDS_OFF) + ui * BM);
        if (!has_next) break;
#pragma unroll
        for (int a = 0; a < 2; ++a)
#pragma unroll
            for (int b = 0; b < 2; ++b)
#pragma unroll
                for (int m = 0; m < 4; ++m)
#pragma unroll
                    for (int n = 0; n < 2; ++n) acc[a][b][m][n] = (f32x4){0.f, 0.f, 0.f, 0.f};
        cur = nxt; cA = nA; cB = nB; ++ui;
        if (wr == 1) PG8_BAR;
    }
    PG8_WAIT_V(0);
    PG8_BAR;
#undef PG8_SA
#undef PG8_SB
#undef PG8_STAGE
#undef PG8_LDA
#undef PG8_LDB
#undef PG8_MMA
#undef PG8_WAIT_V
#undef PG8_WAIT_L
#undef PG8_BAR
#undef PG8_SCHED
}
}

__device__ __forceinline__ void tr_item(const float* __restrict__ W, int ldw, int nvalid, int k0, int n0, bf16_t* WT, int ldk, int drow0,
                                        const float* gain, float* scr, int lane) {
    const int r = lane >> 4, c4 = (lane & 15) * 4;
    f32x4 v[16];
    const bool ok = (n0 + c4) < nvalid;
#pragma unroll
    for (int i = 0; i < 16; ++i) v[i] = ok ? *(const f32x4*)(W + (size_t)(k0 + 4 * i + r) * ldw + n0 + c4) : (f32x4){0.f, 0.f, 0.f, 0.f};
#pragma unroll
    for (int i = 0; i < 16; ++i) { const int kk = 4 * i + r; const float gm = gain ? gain[k0 + kk] : 1.0f; float* d = scr + kk * 65 + c4;
        d[0] = v[i].x * gm; d[1] = v[i].y * gm; d[2] = v[i].z * gm; d[3] = v[i].w * gm; }
    LDS_WAIT();
    const int c = lane & 7;
#pragma unroll
    for (int j = 0; j < 8; ++j) { const int n = (lane >> 3) + 8 * j; const float* p = scr + (8 * c) * 65 + n;
        u32x4 o; o.x = pk2(p[0 * 65], p[1 * 65]); o.y = pk2(p[2 * 65], p[3 * 65]); o.z = pk2(p[4 * 65], p[5 * 65]); o.w = pk2(p[6 * 65], p[7 * 65]);
        *(u32x4*)(WT + (size_t)(drow0 + n) * ldk + k0 + 8 * c) = o; }
    LDS_WAIT();
}

__device__ __forceinline__ void convert_ffn(const Args& a, unsigned char* ws, float* scr, int f, int wk, int nw, int lane, int lo_item = 0, int hi_item = 16 * 88 + 44 * 16) {
    constexpr int I_GU = 16 * 88, I_D = 44 * 16;
    for (int it = lo_item + wk; it < hi_item; it += nw) {
        int r = it;
        if (r < I_GU) { const int kb = r / 88, nb = r % 88, which = nb / 44, n0 = 64 * (nb % 44);
            const float* W = (which ? a.in[4] : a.in[3]) + (size_t)f * DM * DFF;
            tr_item(W, DFF, DFF, 64 * kb, n0, (bf16_t*)(ws + WS_WGU + (size_t)f * 11 * MiB), DM, 256 * (n0 >> 7) + 128 * which + (n0 & 127), a.in[2] + f * DM, scr, lane); continue; }
        r -= I_GU;
        { const int kb = r / 16, nb = r % 16;
            tr_item(a.in[5] + (size_t)f * DFF * DM, DM, DM, 64 * kb, 64 * nb, (bf16_t*)(ws + WS_WD + (size_t)f * (11 * MiB / 2)), DFF, 64 * nb, nullptr, scr, lane); }
    }
}

__device__ __forceinline__ void convert_misc(const Args& a, unsigned char* ws, float* scr, int wk, int nw, int lane) {
    constexpr int I_IN = 16 * 48, I_OUT = 16 * 16, I_P = 64, I_C = 128;
    constexpr int NITEMS = I_IN + I_OUT + I_P + I_C;
    for (int it = wk; it < NITEMS; it += nw) {
        int r = it;
        if (r < I_IN) { const int kb = r / 48, nb = r % 48;
            tr_item(a.in[7], PIN, PIN, 64 * kb, 64 * nb, (bf16_t*)(ws + WS_WIN), DM, 64 * nb, a.in[6], scr, lane); continue; }
        r -= I_IN;
        if (r < I_OUT) { const int kb = r / 16, nb = r % 16;
            tr_item(a.in[14], DM, DM, 64 * kb, 64 * nb, (bf16_t*)(ws + WS_WOUT), DM, 64 * nb, nullptr, scr, lane); continue; }
        r -= I_OUT;
        if (r < I_P) { const int gi = r / 16, rr = r % 16, kb = rr / 4, nb = rr % 4;
            tr_item(a.in[15] + (size_t)gi * 65536, 256, 256, 64 * kb, 64 * nb, (bf16_t*)(ws + WS_WP), 256, gi * 256 + 64 * nb, nullptr, scr, lane); continue; }
        r -= I_P;
        { const int kv = r / 64, rr = r % 64, kb = rr / 2, nb = rr % 2;
            tr_item(a.in[11] + (size_t)kv * 2048 * 128, 128, 128, 64 * kb, 64 * nb, (bf16_t*)(ws + WS_WC1), 2048, kv * 128 + 64 * nb, nullptr, scr, lane); }
    }
    if (wk < 256) { const int kv = wk >> 7, j = wk & 127; const float* pos = a.in[10] + kv * 2048; const float* w1 = a.in[11] + (size_t)kv * 2048 * 128;
        float s = 0.f; for (int k = lane; k < 2048; k += 64) s += pos[k] * w1[(size_t)k * 128 + j];
        s = wave_sum(s); if (lane == 0) ((float*)(ws + WS_MISC))[wk] = s; }
}

__device__ __forceinline__ void prologue(const Args& a, unsigned char* ws, unsigned char* lds, int bid, int wave, int lane, bool late) {
    float* scr = (float*)(lds + wave * 16640);
    const int gw = bid * 8 + wave, NGW = gridDim.x * 8;
    if (late) convert_ffn(a, ws, scr, 0, gw, NGW, lane, 0, 16 * 88);
    else for (int f = 0; f < 4; ++f) convert_ffn(a, ws, scr, f, gw, NGW, lane);
    if (!late) convert_misc(a, ws, scr, gw, NGW, lane);
    const float* x = a.in[0]; bf16_t* XB = (bf16_t*)(ws + WS_XB); float* SS = (float*)(ws + WS_SS);
    for (int m = gw; m < MTOK; m += 2 * NGW) {
        f32x4 v[2][4];
#pragma unroll
        for (int q = 0; q < 2; ++q)
#pragma unroll
            for (int j = 0; j < 4; ++j) v[q][j] = (m + q * NGW < MTOK) ? ((const f32x4*)(x + (size_t)(m + q * NGW) * DM) + lane)[64 * j] : (f32x4){0.f, 0.f, 0.f, 0.f};
#pragma unroll
        for (int q = 0; q < 2; ++q) { const int mm = m + q * NGW; if (mm >= MTOK) break; float s = 0.f; u32x2* o8 = (u32x2*)(XB + (size_t)mm * DM) + lane;
#pragma unroll
            for (int j = 0; j < 4; ++j) { const f32x4 t = v[q][j]; s += (t.x * t.x + t.y * t.y) + (t.z * t.z + t.w * t.w);
                u32x2 w; w.x = pk2(t.x, t.y); w.y = pk2(t.z, t.w); o8[64 * j] = w; }
            s = wave_sum(s);
            if (lane < 16) SS[(size_t)mm * 16 + lane] = (lane == 0) ? s : 0.f; }
    }
}

__device__ __forceinline__ void post_tile(const Args& a, unsigned char* ws, unsigned char* lds, int tile, const int tid) {
    const bf16_t* PROJ = (const bf16_t*)(ws + WS_R1);
    unsigned char* mx = (unsigned char*)a.out;
    bf16_t* Qo = (bf16_t*)mx; bf16_t* KS = (bf16_t*)(mx + 16 * MiB); bf16_t* KW = (bf16_t*)(mx + 20 * MiB);
    bf16_t* VST = (bf16_t*)(mx + 24 * MiB); bf16_t* VWT = (bf16_t*)(mx + 28 * MiB); bf16_t* AO = (bf16_t*)(ws + WS_AO);
    const int row0 = tile * 64, b = row0 >> 13, tpos0 = row0 & (SEQ - 1);
    float* cs = (float*)lds; float* sn = cs + 512;
    { const int tl = tid >> 3, i = tid & 7; const float pos = (float)((const int*)a.in[1])[row0 + tl];
      const float freq = powf(500000.0f, -(float)i * 0.125f); float s, c; sincosf(pos * freq, &s, &c); cs[tl * 8 + i] = c; sn[tl * 8 + i] = s; }
    __syncthreads();
    const float qscale = 0.125f * 1.4426950408889634f;
    const int j = tid & 7;
    float gq8[8], gs8[8], gw8[8];
#pragma unroll
    for (int i = 0; i < 8; ++i) { gq8[i] = a.in[8][8 * j + i]; gs8[i] = a.in[9][64 + 8 * j + i]; gw8[i] = a.in[9][128 + 8 * j + i]; }
#pragma unroll 4
    for (int pass = 0; pass < 12; ++pass) {
        const int unit = pass * 64 + (tid >> 3), tl = unit / 12, hu = unit % 12;
        const int col = hu < 8 ? 64 * hu : (hu < 10 ? 768 + 64 * (hu - 8) : 1024 + 64 * (hu - 10));
        const u32x4 raw = *(const u32x4*)(PROJ + (size_t)(row0 + tl) * PINP + col + 8 * j);
        float v[8] = {bflo(raw.x), bfhi(raw.x), bflo(raw.y), bfhi(raw.y), bflo(raw.z), bfhi(raw.z), bflo(raw.w), bfhi(raw.w)};
        float ss = 0.f;
#pragma unroll
        for (int i = 0; i < 8; ++i) ss += v[i] * v[i];
        ss += __shfl_xor(ss, 1); ss += __shfl_xor(ss, 2); ss += __shfl_xor(ss, 4);
        const float rstd = 1.0f / sqrtf(ss * (1.0f / 64.0f) + 1e-6f);
#pragma unroll
        for (int i = 0; i < 8; ++i) v[i] = v[i] * rstd * (hu < 8 ? gq8[i] : (hu < 10 ? gs8[i] : gw8[i]));
#pragma unroll
        for (int i = 0; i < 8; ++i) { const float pr = __shfl_xor(v[i], 1); const float c = cs[tl * 8 + i], s = sn[tl * 8 + i];
            if (j == 0) v[i] = v[i] * c - pr * s; else if (j == 1) v[i] = v[i] * c + pr * s; }
        const float sc = hu < 8 ? qscale : 1.0f;
        u32x4 o; o.x = pk2(v[0] * sc, v[1] * sc); o.y = pk2(v[2] * sc, v[3] * sc); o.z = pk2(v[4] * sc, v[5] * sc); o.w = pk2(v[6] * sc, v[7] * sc);
        bf16_t* dst = hu < 8 ? Qo + (size_t)(row0 + tl) * 512 + 64 * hu : (hu < 10 ? KS + (size_t)(row0 + tl) * 128 + 64 * (hu - 8) : KW + (size_t)(row0 + tl) * 128 + 64 * (hu - 10));
        *(u32x4*)(dst + 8 * j) = o;
    }
    for (int k = 0; k < 4; ++k) { const int u = tid + 512 * k, du = u & 255, tc = u >> 8, src = du >> 6, d = du & 63;
        const int col = (src < 2 ? 896 : 1152) + (src & 1) * 64 + d;
        unsigned short v[8];
#pragma unroll
        for (int i = 0; i < 8; ++i) v[i] = PROJ[(size_t)(row0 + 8 * tc + i) * PINP + col];
        u32x4 o; o.x = v[0] | ((unsigned)v[1] << 16); o.y = v[2] | ((unsigned)v[3] << 16); o.z = v[4] | ((unsigned)v[5] << 16); o.w = v[6] | ((unsigned)v[7] << 16);
        bf16_t* dst = (src < 2 ? VST : VWT) + ((size_t)(b * 2 + (src & 1)) * 64 + d) * SEQ + tpos0 + 8 * tc;
        *(u32x4*)dst = o; }
    { const int c = 2 * (tid & 255), th = tid >> 8; const float* cw = a.in[13];
      const f32x2 w0 = *(const f32x2*)(cw + c), w1 = *(const f32x2*)(cw + 512 + c), w2 = *(const f32x2*)(cw + 1024 + c);
      const int r0 = row0 + 32 * th;
      f32x2 v1 = {0.f, 0.f}, v2 = {0.f, 0.f};
      if (tpos0 + 32 * th > 0) { const bf16_t* p1 = PROJ + (size_t)(r0 - 1) * PINP; const bf16_t* p2 = PROJ + (size_t)(r0 - 2) * PINP;
          const unsigned g1 = *(const unsigned*)(p1 + 2328 + c), u1 = *(const unsigned*)(p1 + 1304 + c), g2 = *(const unsigned*)(p2 + 2328 + c), u2 = *(const unsigned*)(p2 + 1304 + c);
          v1 = (f32x2){bflo(g1) * bflo(u1), bfhi(g1) * bfhi(u1)}; v2 = (f32x2){bflo(g2) * bflo(u2), bfhi(g2) * bfhi(u2)}; }
#pragma unroll 1
      for (int tb = 0; tb < 32; tb += 8) {
          unsigned uu[8], gb[8], gc[8];
#pragma unroll
          for (int i = 0; i < 8; ++i) { const bf16_t* p = PROJ + (size_t)(r0 + tb + i) * PINP; uu[i] = *(const unsigned*)(p + 1304 + c); gb[i] = *(const unsigned*)(p + 1816 + c); gc[i] = *(const unsigned*)(p + 2328 + c); }
#pragma unroll
          for (int i = 0; i < 8; ++i) { const f32x2 v = (f32x2){bflo(gc[i]) * bflo(uu[i]), bfhi(gc[i]) * bfhi(uu[i])};
              const f32x2 y = w2 * v + w1 * v1 + w0 * v2;
              *(unsigned*)(AO + (size_t)(r0 + tb + i) * DM + 512 + c) = pk2(bflo(gb[i]) * y.x, bfhi(gb[i]) * y.y); v2 = v1; v1 = v; } } }
    __syncthreads();
}

__device__ __forceinline__ void compress_task(const Args& a, unsigned char* ws, unsigned char* lds, int task, const int tid) {
    const int wave = tid >> 6, lane = tid & 63, fr = lane & 15, fq = lane >> 4;
    const bf16_t* PROJ = (const bf16_t*)(ws + WS_R1); const bf16_t* WC1 = (const bf16_t*)(ws + WS_WC1);
    const float* bias1 = (const float*)(ws + WS_MISC);
    bf16_t* KC = (bf16_t*)(ws + WS_MISC + 64 * 1024); bf16_t* VCT = (bf16_t*)(ws + WS_MISC + 512 * 1024);
    const int kv = task >> 7, b = (task >> 6) & 1, g = (task >> 5) & 1, n0 = (task & 31) * 16;
    bf16_t* Hs = (bf16_t*)lds;
    float* Os = (float*)(lds + 8192);
    float* Ps = (float*)(lds + 16384);
    {
        f32x4 acc[8];
#pragma unroll
        for (int nt = 0; nt < 8; ++nt) acc[nt] = (f32x4){0.f, 0.f, 0.f, 0.f};
        const bf16_t* ap = PROJ + 512 + kv * 128 + g * 64 + 8 * fq;
        const bf16_t* bp = WC1 + (size_t)(kv * 128 + fr) * 2048 + 256 * wave + 8 * fq;
        const int n = n0 + fr;
#pragma unroll 2
        for (int ks = 0; ks < 8; ++ks) { const int kk = 8 * wave + ks; int tok = 16 * n + (kk >> 1); tok = tok > SEQ - 1 ? SEQ - 1 : tok;
            const bf16x8 af = *(const bf16x8*)(ap + (size_t)(b * SEQ + tok) * PINP + (kk & 1) * 32);
            bf16x8 bfr[8];
#pragma unroll
            for (int nt = 0; nt < 8; ++nt) bfr[nt] = *(const bf16x8*)(bp + (size_t)nt * 16 * 2048 + ks * 32);
#pragma unroll
            for (int nt = 0; nt < 8; ++nt) acc[nt] = mfma16(af, bfr[nt], acc[nt]); }
#pragma unroll
        for (int nt = 0; nt < 8; ++nt)
#pragma unroll
            for (int jj = 0; jj < 4; ++jj) Ps[(wave * 16 + 4 * fq + jj) * 132 + 16 * nt + fr] = acc[nt][jj];
    }
    __syncthreads();
    {
        const int row = tid >> 5, col = (tid & 31) * 4;
        f32x4 sm = {0.f, 0.f, 0.f, 0.f};
#pragma unroll
        for (int w = 0; w < 8; ++w) sm += *(const f32x4*)(Ps + (w * 16 + row) * 132 + col);
        unsigned short hv[4];
#pragma unroll
        for (int i = 0; i < 4; ++i) { const float x = sm[i] + bias1[kv * 128 + col + i]; const float u = 0.7978845608028654f * (x + 0.044715f * x * x * x);
            const float th = 1.0f - 2.0f / (__expf(2.0f * u) + 1.0f); hv[i] = (unsigned short)f2bf(0.5f * x * (1.0f + th)); }
        u32x2 o; o.x = hv[0] | ((unsigned)hv[1] << 16); o.y = hv[2] | ((unsigned)hv[3] << 16);
        *(u32x2*)(Hs + row * 136 + col) = o;
    }
    __syncthreads();
    if (wave < 4) { const int dt = wave; f32x4 acc = {0.f, 0.f, 0.f, 0.f}; const float* w2 = a.in[12] + (size_t)kv * 128 * 64;
#pragma unroll
        for (int kk = 0; kk < 4; ++kk) { const bf16x8 af = *(const bf16x8*)(Hs + fr * 136 + kk * 32 + 8 * fq);
            float wv[8];
#pragma unroll
            for (int i = 0; i < 8; ++i) wv[i] = w2[(size_t)(kk * 32 + 8 * fq + i) * 64 + 16 * dt + fr];
            u32x4 bw; bw.x = pk2(wv[0], wv[1]); bw.y = pk2(wv[2], wv[3]); bw.z = pk2(wv[4], wv[5]); bw.w = pk2(wv[6], wv[7]);
            acc = mfma16(af, __builtin_bit_cast(bf16x8, bw), acc); }
#pragma unroll
        for (int jj = 0; jj < 4; ++jj) Os[(4 * fq + jj) * 65 + 16 * dt + fr] = acc[jj]; }
    __syncthreads();
    if (kv == 0) {
        if (tid < 128) { const int nl = tid >> 3, j = tid & 7, n = n0 + nl; float v[8]; float ss = 0.f;
#pragma unroll
            for (int i = 0; i < 8; ++i) { v[i] = Os[nl * 65 + 8 * j + i]; ss += v[i] * v[i]; }
            ss += __shfl_xor(ss, 1); ss += __shfl_xor(ss, 2); ss += __shfl_xor(ss, 4);
            const float rstd = 1.0f / sqrtf(ss * (1.0f / 64.0f) + 1e-6f);
            int ptok = 16 * n + 31; ptok = ptok > SEQ - 1 ? SEQ - 1 : ptok;
            const float pos = (float)((const int*)a.in[1])[b * SEQ + ptok];
#pragma unroll
            for (int i = 0; i < 8; ++i) v[i] = v[i] * rstd * a.in[9][8 * j + i];
#pragma unroll
            for (int i = 0; i < 8; ++i) { const float pr = __shfl_xor(v[i], 1);
                if (j < 2) { const float freq = powf(500000.0f, -(float)i * 0.125f); float s, c; sincosf(pos * freq, &s, &c);
                    v[i] = (j == 0) ? v[i] * c - pr * s : v[i] * c + pr * s; } }
            u32x4 o; o.x = pk2(v[0], v[1]); o.y = pk2(v[2], v[3]); o.z = pk2(v[4], v[5]); o.w = pk2(v[6], v[7]);
            if (n >= 511) o = (u32x4){0u, 0u, 0u, 0u};
            *(u32x4*)(KC + ((size_t)(b * 512 + n) * 2 + g) * 64 + 8 * j) = o; }
    } else {
        if (tid < 64) { const int d = tid; unsigned w[8];
#pragma unroll
            for (int i = 0; i < 8; ++i) { const float v0 = (n0 + 2 * i >= 511) ? 0.f : Os[(2 * i) * 65 + d], v1 = (n0 + 2 * i + 1 >= 511) ? 0.f : Os[(2 * i + 1) * 65 + d]; w[i] = pk2(v0, v1); }
            u32x4* dst = (u32x4*)(VCT + ((size_t)(b * 2 + g) * 64 + d) * 512 + n0);
            dst[0] = (u32x4){w[0], w[1], w[2], w[3]}; dst[1] = (u32x4){w[4], w[5], w[6], w[7]}; }
    }
    __syncthreads();
}

constexpr int AT_TPS = 2, AT_TILE = 18432, AT_STAGE = AT_TPS * AT_TILE, AT_FIN = 2 * AT_STAGE, AT_IMP_STRIDE = 8256, AT_SELM = AT_FIN + 8 * AT_IMP_STRIDE;
struct AttnPtrs { const bf16_t *Q, *KS, *KW, *VST, *VWT, *KC, *VCT, *PROJ; bf16_t* AO; const float *qn, *kn; };

template <int MODE, bool MASKED>
__device__ __forceinline__ void attn_tile(const unsigned char* buf, int key0, int lane, const bf16x8 (&Q)[2][2], f32x4 (&O)[2][4], float (&l)[2],
                                          float ci, int lo, unsigned cnt, const float (&inv)[2], float* imp, float& prev) {
    const int fr = lane & 15, fq = lane >> 4;
    bf16x8 kf[4][2];
#pragma unroll
    for (int kt = 0; kt < 4; ++kt)
#pragma unroll
        for (int ds = 0; ds < 2; ++ds) kf[kt][ds] = *(const bf16x8*)(buf + (16 * kt + fr) * 144 + 64 * ds + 16 * fq);
    bool vm[16];
    if (MASKED) {
#pragma unroll
        for (int i = 0; i < 16; ++i) vm[i] = (unsigned)(key0 + 16 * (i >> 2) + 4 * fq + (i & 3) - lo) < cnt;
    }
    float w[16];
#pragma unroll
    for (int i = 0; i < 16; ++i) w[i] = 0.f;
    u32x4 pk[2][2];
#pragma unroll
    for (int h = 0; h < 2; ++h) {
        f32x4 sc[4];
#pragma unroll
        for (int kt = 0; kt < 4; ++kt) { f32x4 t = {ci, ci, ci, ci}; t = mfma16(kf[kt][0], Q[h][0], t); sc[kt] = mfma16(kf[kt][1], Q[h][1], t); }
        float p[16];
#pragma unroll
        for (int kt = 0; kt < 4; ++kt)
#pragma unroll
            for (int i = 0; i < 4; ++i) { const float e = __builtin_amdgcn_exp2f(sc[kt][i]); p[4 * kt + i] = MASKED ? (vm[4 * kt + i] ? e : 0.f) : e; }
        if (MODE == 1) {
#pragma unroll
            for (int i = 0; i < 16; ++i) { p[i] *= inv[h]; w[i] += p[i]; }
        } else {
            l[h] += (((p[0] + p[1]) + (p[2] + p[3])) + ((p[4] + p[5]) + (p[6] + p[7]))) + (((p[8] + p[9]) + (p[10] + p[11])) + ((p[12] + p[13]) + (p[14] + p[15])));
        }
        if (MODE >= 1) {
#pragma unroll
            for (int hf = 0; hf < 2; ++hf) { pk[h][hf].x = cvt_pk_bf16(p[8 * hf + 0], p[8 * hf + 1]); pk[h][hf].y = cvt_pk_bf16(p[8 * hf + 2], p[8 * hf + 3]);
                pk[h][hf].z = cvt_pk_bf16(p[8 * hf + 4], p[8 * hf + 5]); pk[h][hf].w = cvt_pk_bf16(p[8 * hf + 6], p[8 * hf + 7]); }
        }
    }
    if (MODE >= 1) {
#pragma unroll
        for (int hf = 0; hf < 2; ++hf) {
            bf16x8 vf[4];
#pragma unroll
            for (int dt = 0; dt < 4; ++dt) { const unsigned char* vp = buf + 9216 + (16 * dt + fr) * 144 + (32 * hf + 4 * fq) * 2;
                const u32x2 a0 = *(const u32x2*)vp, a1 = *(const u32x2*)(vp + 32);
                vf[dt] = __builtin_bit_cast(bf16x8, (u32x4){a0.x, a0.y, a1.x, a1.y}); }
#pragma unroll
            for (int dt = 0; dt < 4; ++dt)
#pragma unroll
                for (int h = 0; h < 2; ++h) O[h][dt] = mfma16(vf[dt], __builtin_bit_cast(bf16x8, pk[h][hf]), O[h][dt]);
        }
    }
    if (MODE == 1) {
#pragma unroll
        for (int kt = 0; kt < 4; ++kt) {
            const float w3 = w[4 * kt + 3], sum4 = (w[4 * kt] + w[4 * kt + 1]) + (w[4 * kt + 2] + w3);
            const float rc = __shfl(w3, (lane + 48) & 63), rp = __shfl(prev, (lane + 48) & 63);
            const float spill = fq ? rc : rp; prev = w3;
            imp[fr * 129 + 4 * ((key0 >> 4) + kt) + fq] = sum4 + spill;
        }
    }
}

template <int MODE, bool FLAGGED>
__device__ __forceinline__ void attn_stream(unsigned char* lds, const bf16_t* __restrict__ Kg, const bf16_t* __restrict__ VTg, int vpitch, int kstart, int nst,
                                            const int tid, const int lane, const bf16x8 (&Q)[2][2], f32x4 (&O)[2][4], float (&l)[2], float cinit,
                                            int lo, unsigned cnt, const unsigned long long sel_lo, const unsigned long long sel_hi, int tpos, const float (&inv)[2], float* imp, float& prev) {
    int tid_o = tid, lane_o = lane; asm volatile("" : "+v"(tid_o), "+v"(lane_o));
    const int lr = tid_o >> 3, lc = tid_o & 7, t0w = tpos - (lane & 15);
    const int nstage = (nst + AT_TPS - 1) / AT_TPS;
    {
#pragma unroll
        for (int u = 0; u < AT_TPS; ++u) if (u < nst) {
            const u32x4 kr = *(const u32x4*)(Kg + (size_t)(kstart + 64 * u + lr) * 128 + 8 * lc), vr = *(const u32x4*)(VTg + (size_t)lr * vpitch + kstart + 64 * u + 8 * lc);
            *(u32x4*)(lds + u * AT_TILE + lr * 144 + 16 * lc) = kr; *(u32x4*)(lds + u * AT_TILE + 9216 + lr * 144 + 16 * lc) = vr; }
    }
    __syncthreads();
    for (int sg = 0; sg < nstage; ++sg) {
#pragma unroll 1
        for (int u = 0; u < AT_TPS; ++u) {
            const int ti = sg * AT_TPS + u, tn = ti + AT_TPS;
            const bool pre = tn < nst;
            u32x4 kr, vr;
            if (pre) { kr = *(const u32x4*)(Kg + (size_t)(kstart + 64 * tn + lr) * 128 + 8 * lc); vr = *(const u32x4*)(VTg + (size_t)lr * vpitch + kstart + 64 * tn + 8 * lc); }
            if (ti < nst) {
                const int key0 = kstart + 64 * ti;
                const unsigned char* buf = lds + (sg & 1) * AT_STAGE + u * AT_TILE;
                if (FLAGGED) {
                    const int j = key0 >> 6; const unsigned long long wsel = (j < 64) ? sel_lo : sel_hi;
                    const bool flag = (wsel >> (j & 63)) & 1ull;
                    if (__ballot(flag) != 0ull) {
                        if (key0 + 63 <= t0w) attn_tile<MODE, false>(buf, key0, lane_o, Q, O, l, flag ? cinit : -30000.0f, 0, 0u, inv, imp, prev);
                        else attn_tile<MODE, true>(buf, key0, lane_o, Q, O, l, cinit, 0, flag ? (unsigned)(tpos + 1) : 0u, inv, imp, prev);
                    }
                } else {
                    const bool allv = ((unsigned)(key0 - lo) < cnt) && ((unsigned)(key0 + 63 - lo) < cnt);
                    if (__ballot(!allv) == 0ull) attn_tile<MODE, false>(buf, key0, lane_o, Q, O, l, cinit, lo, cnt, inv, imp, prev);
                    else attn_tile<MODE, true>(buf, key0, lane_o, Q, O, l, cinit, lo, cnt, inv, imp, prev);
                }
            }
            if (pre) { unsigned char* nb = lds + ((sg + 1) & 1) * AT_STAGE + u * AT_TILE;
                *(u32x4*)(nb + lr * 144 + 16 * lc) = kr; *(u32x4*)(nb + 9216 + lr * 144 + 16 * lc) = vr; }
        }
        __syncthreads();
    }
}

__device__ __forceinline__ void attn_chunk(const AttnPtrs& P, unsigned char* lds, int b, int g, int c, const int tid, int wave, int lane) {
    const int fr = lane & 15, fq = lane >> 4, tt = wave & 3, hp = wave >> 2;
    const int t0 = 64 * c + 16 * tt, tpos = t0 + fr;
    const size_t rowbase = (size_t)b * SEQ;
    f32x4* fin = (f32x4*)(lds + AT_FIN + (tt * 2 + hp) * 8192);
    float* imp = (float*)(lds + AT_FIN + (tt * 2 + hp) * AT_IMP_STRIDE);
    const float* impA = (const float*)(lds + AT_FIN + (tt * 2) * AT_IMP_STRIDE);
    const float* impB = (const float*)(lds + AT_FIN + (tt * 2 + 1) * AT_IMP_STRIDE);
    unsigned* selm = (unsigned*)(lds + AT_SELM + tt * 256);
    bf16x8 Q[2][2];
#pragma unroll
    for (int h = 0; h < 2; ++h)
#pragma unroll
        for (int ds = 0; ds < 2; ++ds) Q[h][ds] = *(const bf16x8*)(P.Q + (rowbase + tpos) * 512 + (g * 4 + 2 * hp + h) * 64 + 32 * ds + 8 * fq);
    const float mq = wave_max(fabsf(P.qn[lane]));
    const float c0 = -(8.0f * mq * wave_max(fabsf(P.kn[lane])) * 1.03f * 1.4426950408889634f + 0.1f);
    const float c1 = -(8.0f * mq * wave_max(fabsf(P.kn[64 + lane])) * 1.03f * 1.4426950408889634f + 0.1f);
    const float c2 = -(8.0f * mq * wave_max(fabsf(P.kn[128 + lane])) * 1.03f * 1.4426950408889634f + 0.1f);
    f32x4 O[2][4]; float l[2], inv[2] = {0.f, 0.f}; float prev = 0.f; unsigned long long sel_lo = 0ull, sel_hi = 0ull;
#define ZERO_O() do { _Pragma("unroll") for (int h = 0; h < 2; ++h) { l[h] = 0.f; _Pragma("unroll") for (int dt = 0; dt < 4; ++dt) O[h][dt] = (f32x4){0.f, 0.f, 0.f, 0.f}; } } while (0)
#define REDUCE_L() do { _Pragma("unroll") for (int h = 0; h < 2; ++h) { l[h] += __shfl_xor(l[h], 16); l[h] += __shfl_xor(l[h], 32); } } while (0)
    const bf16_t* KCg = P.KC + (size_t)b * 512 * 128 + g * 64;
    const bf16_t* VCTg = P.VCT + (size_t)(b * 2 + g) * 64 * 512;
    const int nlim = (tpos >= 31) ? ((tpos - 31) >> 4) : -1;
    const int ncs = (4 * c + 3 + 63) >> 6;
    for (int i = lane; i < 16 * 129; i += 64) imp[i] = 0.f;
    ZERO_O();
    attn_stream<0, false>(lds, KCg, VCTg, 512, 0, ncs, tid, lane, Q, O, l, c0, 0, (unsigned)(nlim + 1), sel_lo, sel_hi, tpos, inv, imp, prev);
    REDUCE_L();
#pragma unroll
    for (int h = 0; h < 2; ++h) inv[h] = l[h] > 0.f ? 1.0f / l[h] : 0.f;
    attn_stream<1, false>(lds, KCg, VCTg, 512, 0, ncs, tid, lane, Q, O, l, c0, 0, (unsigned)(nlim + 1), sel_lo, sel_hi, tpos, inv, imp, prev);
    const unsigned long long ltmask = (1ull << lane) - 1ull;
    for (int tk = 8 * hp; tk < 8 * hp + 8; ++tk) {
        const int cur = (t0 + tk) >> 6;
        const float v0 = impA[tk * 129 + lane] + impB[tk * 129 + lane], v1 = impA[tk * 129 + 64 + lane] + impB[tk * 129 + 64 + lane];
        const unsigned k0 = (lane > cur) ? 0u : ((lane == 0 || lane == cur) ? 0x461C4000u : __builtin_bit_cast(unsigned, v0));
        const unsigned k1 = (lane + 64 > cur) ? 0u : ((lane + 64 == cur) ? 0x461C4000u : __builtin_bit_cast(unsigned, v1));
        unsigned T = 0u;
        for (int bit = 30; bit >= 0; --bit) { const unsigned cand = T | (1u << bit);
            const int cntc = __popcll(__ballot(k0 >= cand)) + __popcll(__ballot(k1 >= cand)); if (cntc >= 16) T = cand; }
        const unsigned long long bg0 = __ballot(k0 > T), bg1 = __ballot(k1 > T);
        const int need = 16 - __popcll(bg0) - __popcll(bg1);
        const unsigned long long be0 = __ballot(k0 == T), be1 = __ballot(k1 == T);
        const int r0 = __popcll(be0 & ltmask), r1 = __popcll(be0) + __popcll(be1 & ltmask);
        const bool s0 = (k0 > T) || ((k0 == T) && r0 < need), s1 = (k1 > T) || ((k1 == T) && r1 < need);
        const unsigned long long m0 = __ballot(s0), m1 = __ballot(s1);
        if (lane == 0) { selm[tk * 4 + 0] = (unsigned)m0; selm[tk * 4 + 1] = (unsigned)(m0 >> 32); selm[tk * 4 + 2] = (unsigned)m1; selm[tk * 4 + 3] = (unsigned)(m1 >> 32); }
    }
    __syncthreads();
    sel_lo = (unsigned long long)selm[fr * 4 + 0] | ((unsigned long long)selm[fr * 4 + 1] << 32);
    sel_hi = (unsigned long long)selm[fr * 4 + 2] | ((unsigned long long)selm[fr * 4 + 3] << 32);
    int tpos_l = tpos; asm volatile("" : "+v"(tpos_l));
#define GATE(h, br) (1.0f / (1.0f + __expf(-bf2f(P.PROJ[(rowbase + tpos_l) * PINP + 1280 + g * 12 + hp * 6 + (h) * 3 + (br)]))))
#pragma unroll
    for (int h = 0; h < 2; ++h)
#pragma unroll
        for (int dt = 0; dt < 4; ++dt) fin[(h * 4 + dt) * 64 + lane] = O[h][dt] * GATE(h, 0);
    ZERO_O();
    attn_stream<2, true>(lds, P.KS + rowbase * 128 + g * 64, P.VST + (size_t)(b * 2 + g) * 64 * SEQ, SEQ, 0, c + 1, tid, lane, Q, O, l, c1, 0, 0u, sel_lo, sel_hi, tpos, inv, imp, prev);
    REDUCE_L();
#pragma unroll
    for (int h = 0; h < 2; ++h) { const float sc = GATE(h, 1) / l[h];
#pragma unroll
        for (int dt = 0; dt < 4; ++dt) fin[(h * 4 + dt) * 64 + lane] += O[h][dt] * sc; }
    ZERO_O();
    { int kbeg = 64 * c - 512; kbeg = kbeg < 0 ? 0 : kbeg;
      attn_stream<2, false>(lds, P.KW + rowbase * 128 + g * 64, P.VWT + (size_t)(b * 2 + g) * 64 * SEQ, SEQ, kbeg, (64 * c + 64 - kbeg) >> 6, tid, lane, Q, O, l, c2, tpos - 511, 512u, sel_lo, sel_hi, tpos, inv, imp, prev); }
    REDUCE_L();
    int lane_l = lane; asm volatile("" : "+v"(lane_l), "+v"(tpos_l));
    bf16_t* op = P.AO + (rowbase + tpos_l) * DM + g * 256 + hp * 128 + 4 * (lane_l >> 4);
#pragma unroll
    for (int h = 0; h < 2; ++h) { const float sc = GATE(h, 2) / l[h];
#pragma unroll
        for (int dt = 0; dt < 4; ++dt) { const f32x4 v = fin[(h * 4 + dt) * 64 + lane] + O[h][dt] * sc;
            u32x2 w; w.x = cvt_pk_bf16(v[0], v[1]); w.y = cvt_pk_bf16(v[2], v[3]); *(u32x2*)(op + h * 64 + 16 * dt) = w; } }
    __syncthreads();
#undef ZERO_O
#undef REDUCE_L
#undef GATE
}

__device__ __forceinline__ void pool_tile(const Args& a, unsigned char* ws, unsigned char* lds, int tile, const int tid) {
    const bf16_t* X = (const bf16_t*)(ws + WS_XB); bf16_t* PD = (bf16_t*)(ws + WS_AO); const float* SS = (const float*)(ws + WS_SS);
    const int row0 = tile * 64, tpos0 = row0 & (SEQ - 1);
    float* rs = (float*)lds;
    if (tid < 80) rs[tid] = (tpos0 - 16 + tid >= 0) ? pg8::rstd_of(SS, row0 - 16 + tid) : 0.f;
    __syncthreads();
    const int c = 2 * tid, win = 2 << (c >> 8);
    const f32x2 gn = *(const f32x2*)(a.in[6] + DM + c);
    f32x2 xo[16], xn[16];
#pragma unroll
    for (int j = 0; j < 16; ++j) { const unsigned xw = (tpos0 - 16 + j >= 0) ? *(const unsigned*)(X + (size_t)(row0 - 16 + j) * DM + c) : 0u; xo[j] = (f32x2){bflo(xw), bfhi(xw)} * rs[j]; }
#pragma unroll 1
    for (int sub = 0; sub < 4; ++sub) {
#pragma unroll
        for (int j = 0; j < 16; ++j) { const unsigned xw = *(const unsigned*)(X + (size_t)(row0 + 16 * sub + j) * DM + c); xn[j] = (f32x2){bflo(xw), bfhi(xw)} * rs[16 + 16 * sub + j]; }
#define PX(k) ((k) >= 0 ? xn[(k) >= 0 ? (k) : 0] : xo[(k) >= 0 ? 0 : 16 + (k)])
#pragma unroll
        for (int t = 0; t < 16; ++t) {
            f32x2 sm = xn[t] + PX(t - 1);
            if (win >= 4) sm += PX(t - 2) + PX(t - 3);
            if (win >= 8) sm += (PX(t - 4) + PX(t - 5)) + (PX(t - 6) + PX(t - 7));
            if (win >= 16) sm += ((PX(t - 8) + PX(t - 9)) + (PX(t - 10) + PX(t - 11))) + ((PX(t - 12) + PX(t - 13)) + (PX(t - 14) + PX(t - 15)));
            const int cn = min(tpos0 + 16 * sub + t + 1, win); const float ic = 1.0f / (float)cn;
            const f32x2 o = gn * (sm * ic - xn[t]);
            *(unsigned*)(PD + (size_t)(row0 + 16 * sub + t) * DM + c) = pk2(o.x, o.y);
        }
#undef PX
#pragma unroll
        for (int j = 0; j < 16; ++j) xo[j] = xn[j];
    }
    __syncthreads();
}

#define XB_TMO      128
#define XB_XCNT(j)  (256  + 64 * (j))
#define XB_XSUB(j)  (1280 + 64 * (j))
#define XB_XGEN(j)  (2304 + 64 * (j))
#define XB_TOP      3328
#define XB_TOPGEN   3392
#define XCD_BAR_WORDS 3456
#define XB_SPIN_CAP (1u << 18)
__device__ __forceinline__ unsigned xb_ld(unsigned* p)              { return __hip_atomic_load(p, __ATOMIC_RELAXED, __HIP_MEMORY_SCOPE_AGENT); }
__device__ __forceinline__ unsigned xb_add(unsigned* p, unsigned v) { return __hip_atomic_fetch_add(p, v, __ATOMIC_RELAXED, __HIP_MEMORY_SCOPE_AGENT); }
__device__ __forceinline__ unsigned xb_xcc_id() { return (unsigned)__builtin_amdgcn_s_getreg((3 << 11) | 20) & 0xFu; }
#define XB_SPIN(cond, bar) do { unsigned _sp = 0; while (cond) { __builtin_amdgcn_s_sleep(1); \
    if ((++_sp & 255u) == 0u) { if (xb_ld(&(bar)[XB_TMO])) break; if (_sp > XB_SPIN_CAP) { atomicAdd(&(bar)[XB_TMO], 1u); break; } } } } while (0)
struct XcdBarrier { unsigned* bar; unsigned x; volatile unsigned* st; };
__device__ __forceinline__ void xcd_barrier_complete(unsigned* bar, unsigned x, unsigned& nloc, unsigned& nx) {
    const unsigned G = gridDim.x * gridDim.y * gridDim.z;
    unsigned sum, cnt, mine, sp = 0u;
    for (;;) {
        sum = 0u; cnt = 0u; mine = 0u;
#pragma unroll
        for (unsigned j = 0; j < 16; ++j) { const unsigned c = xb_ld(&bar[XB_XCNT(j)]); sum += c; cnt += (c > 0u) ? 1u : 0u; mine = (j == x) ? c : mine; }
        if (sum == G) break;
        __builtin_amdgcn_s_sleep(1);
        if ((++sp & 255u) == 0u) { if (xb_ld(&bar[XB_TMO])) break; if (sp > XB_SPIN_CAP) { atomicAdd(&bar[XB_TMO], 1u); break; } }
    }
    nloc = mine > 0u ? mine : 1u; nx = cnt > 0u ? cnt : 1u;
}
__device__ __forceinline__ void xcd_barrier(const XcdBarrier& b, const int tid) {
    asm volatile("s_waitcnt vmcnt(0) lgkmcnt(0)" ::: "memory");
    __syncthreads();
    if (tid == 0) {
        unsigned* bar = b.bar;
        __builtin_amdgcn_s_waitcnt(0);
        unsigned nloc = b.st[0], nx = b.st[1];
        if (nloc == 0u) { xcd_barrier_complete(bar, b.x, nloc, nx); b.st[0] = nloc; b.st[1] = nx; }
        const unsigned old = xb_add(&bar[XB_XSUB(b.x)], 1u);
        const unsigned gen = old / nloc;
        if (old + 1u == (gen + 1u) * nloc) {
            __builtin_amdgcn_fence(__ATOMIC_RELEASE, "agent");
            asm volatile("s_waitcnt vmcnt(0)" ::: "memory");
            const unsigned og = xb_add(&bar[XB_TOP], 1u);
            const unsigned tg = og / nx;
            if (og + 1u == (tg + 1u) * nx) xb_add(&bar[XB_TOPGEN], 1u);
            else XB_SPIN(xb_ld(&bar[XB_TOPGEN]) == tg, bar);
            __builtin_amdgcn_fence(__ATOMIC_ACQUIRE, "agent");
            xb_add(&bar[XB_XGEN(b.x)], 1u);
            asm volatile("s_waitcnt vmcnt(0)" ::: "memory");
        } else {
            XB_SPIN(xb_ld(&bar[XB_XGEN(b.x)]) == gen, bar);
            __builtin_amdgcn_fence(__ATOMIC_ACQUIRE, "agent");
            asm volatile("s_waitcnt vmcnt(0)" ::: "memory");
        }
    }
    __syncthreads();
}

__global__ void __launch_bounds__(512, 2) mega_fwd(Args a) {
    extern __shared__ __attribute__((aligned(16))) unsigned char lds[];
    cg::grid_group grid = cg::this_grid();
    const int G = gridDim.x;
    XcdBarrier xbar; xbar.bar = (unsigned*)a.ws; xbar.x = xb_xcc_id(); xbar.st = (volatile unsigned*)(lds + LDS_ST_OFF);
    if (threadIdx.x < 2) xbar.st[threadIdx.x] = 0u;
    if (blockIdx.x == 0) for (int i = threadIdx.x; i < XCD_BAR_WORDS; i += 512) __hip_atomic_store(&xbar.bar[i], 0u, __ATOMIC_RELAXED, __HIP_MEMORY_SCOPE_AGENT);
    asm volatile("s_waitcnt vmcnt(0) lgkmcnt(0)" ::: "memory");
    grid.sync();
    if (threadIdx.x == 0) (void)xb_add(&xbar.bar[XB_XCNT(xbar.x)], 1u);
#pragma unroll 1
    for (int ph = 0; ph < NPH_RUN; ++ph) {
        int tid = threadIdx.x; asm volatile("" : "+v"(tid));
        int bid = blockIdx.x; asm volatile("" : "+s"(bid));
        size_t ws_o = 0; asm volatile("" : "+s"(ws_o));
        unsigned char* ws = a.ws + ws_o;
        const int wave = __builtin_amdgcn_readfirstlane(tid >> 6), lane = tid & 63;
        bf16_t* XB = (bf16_t*)(ws + WS_XB); float* SS = (float*)(ws + WS_SS); bf16_t* R1 = (bf16_t*)(ws + WS_R1); bf16_t* AO = (bf16_t*)(ws + WS_AO);
        if (ph == 0) {
            prologue(a, ws, lds, bid, wave, lane, G == 256);
        } else if (ph == 1 || ph == 7 || ph == 9 || ph == 13) {
            const int f = ph == 1 ? 0 : ph == 7 ? 1 : ph == 9 ? 2 : 3;
            pg8::Gemm g{XB, (const bf16_t*)(ws + WS_WGU + (size_t)f * 11 * MiB), MTOK, 2 * DFF, DM, DM, DM, 0};
            pg8::StaticOrder S; S.init(MTOK, 2 * DFF, G, bid);
            pg8::EpiGU E{R1, SS};
            pg8::gemm_phase<pg8::EpiGU>((LAS unsigned char*)lds, g, S, E, tid);
            if (G == 256 && f < 3 && bid >= 128) { float* scr = (float*)(lds + wave * 16640); const int wk = (bid - 128) * 8 + wave;
                if (f == 0) { convert_ffn(a, ws, scr, 0, wk, 1024, lane, 16 * 88, 16 * 88 + 44 * 16); convert_misc(a, ws, scr, wk, 1024, lane); }
                convert_ffn(a, ws, scr, f + 1, wk, 1024, lane); }
        } else if (ph == 2 || ph == 6 || ph == 8 || ph == 10 || ph == 12 || ph == 14) {
            pg8::Gemm g; pg8::EpiRes E;
            if (ph == 6) { g = pg8::Gemm{AO, (const bf16_t*)(ws + WS_WOUT), MTOK, DM, DM, DM, DM, 0}; E = pg8::EpiRes{XB, nullptr, SS, nullptr, 1.0f}; }
            else if (ph == 12) { g = pg8::Gemm{AO, (const bf16_t*)(ws + WS_WP), MTOK, DM, 256, DM, 256, 256}; E = pg8::EpiRes{XB, nullptr, SS, a.in[16], 1.0f}; }
            else { const int f = ph == 2 ? 0 : ph == 8 ? 1 : ph == 10 ? 2 : 3;
                g = pg8::Gemm{R1, (const bf16_t*)(ws + WS_WD + (size_t)f * (11 * MiB / 2)), MTOK, DM, DFF, DFF, DFF, 0};
                E = pg8::EpiRes{XB, ph == 14 ? a.out : nullptr, ph == 14 ? nullptr : SS, nullptr, 0.5f}; }
            pg8::StaticOrder S; S.init(MTOK, DM, G, bid);
            pg8::gemm_phase<pg8::EpiRes>((LAS unsigned char*)lds, g, S, E, tid);
        } else if (ph == 3) {
            pg8::Gemm g{XB, (const bf16_t*)(ws + WS_WIN), MTOK, PINP, DM, DM, DM, 0};
            pg8::StaticOrder S; S.init(MTOK, PINP, G, bid);
            pg8::EpiProj E{R1, SS};
            pg8::gemm_phase<pg8::EpiProj>((LAS unsigned char*)lds, g, S, E, tid);
        } else if (ph == 4) {
            for (int s = bid; s < 256; s += G) { post_tile(a, ws, lds, s, tid); compress_task(a, ws, lds, s, tid); }
        } else if (ph == 5) {
            const unsigned char* mx = (const unsigned char*)a.out;
            AttnPtrs P; P.Q = (const bf16_t*)mx; P.KS = (const bf16_t*)(mx + 16 * MiB); P.KW = (const bf16_t*)(mx + 20 * MiB);
            P.VST = (const bf16_t*)(mx + 24 * MiB); P.VWT = (const bf16_t*)(mx + 28 * MiB);
            P.KC = (const bf16_t*)(ws + WS_MISC + 64 * 1024); P.VCT = (const bf16_t*)(ws + WS_MISC + 512 * 1024); P.PROJ = R1; P.AO = AO;
            P.qn = a.in[8]; P.kn = a.in[9];
            if (wave < 4) __builtin_amdgcn_s_setprio(1);
            for (int s = bid; s < 256; s += G) {
                const int b = (s >> 1) & 1, gq = s & 1, cp = s >> 2;
                attn_chunk(P, lds, b, gq, cp, tid, wave, lane);
                attn_chunk(P, lds, b, gq, 127 - cp, tid, wave, lane);
            }
            __builtin_amdgcn_s_setprio(0);
        } else if (ph == 11) {
            for (int s = bid; s < 256; s += G) pool_tile(a, ws, lds, s, tid);
        }
        if (ph != NPH_RUN - 1) xcd_barrier(xbar, tid);
    }
}

extern "C" void kernel_launch(void* const* d_in, const int* in_sizes, int n_in, void* d_out, int out_size, void* d_ws, size_t ws_size, hipStream_t stream) {
    static int grid = 0;
    if (grid == 0) {
        int dev = 0, cus = 0, per_cu = 0;
        hipGetDevice(&dev);
        hipDeviceGetAttribute(&cus, hipDeviceAttributeMultiprocessorCount, dev);
        hipFuncSetAttribute((const void*)mega_fwd, hipFuncAttributeMaxDynamicSharedMemorySize, LDS_BYTES);
        hipOccupancyMaxActiveBlocksPerMultiprocessor(&per_cu, (const void*)mega_fwd, 512, LDS_BYTES);
        if (per_cu < 1) { fprintf(stderr, "kernel_launch: occupancy query says %d blocks per CU\n", per_cu); per_cu = 1; }
        if (per_cu > 1) per_cu = 1;
        grid = cus * per_cu;
        if (grid > 256) grid = 256;
    }
    Args a{};
    for (int i = 0; i < 17; ++i) a.in[i] = (const float*)d_in[i];
    a.out = (float*)d_out; a.ws = (unsigned char*)d_ws;
    void* args[] = {&a};
    hipError_t e = hipLaunchCooperativeKernel((const void*)mega_fwd, dim3(grid), dim3(512), args, LDS_BYTES, stream);
    if (e != hipSuccess) fprintf(stderr, "cooperative launch failed: %s (grid %d)\n", hipGetErrorString(e), grid);
}
```
